# Optimizing an MI355X kernel written in HIP

```python
import math
import jax, jax.numpy as jnp
from jax import lax
import numpy as np

D_MODEL = 2048
BATCH = 4
SEQ = 2048
DEPTH = 1

N_HEADS_DIFF = 8
DIFF_HEAD_DIM = 64
DIFF_WIDTH = N_HEADS_DIFF * 2 * DIFF_HEAD_DIM
N_HEADS_MOBA = 8
MOBA_HEAD_DIM = 128
MOBA_WIDTH = N_HEADS_MOBA * MOBA_HEAD_DIM
MOBA_BLOCK = 256
MOBA_TOPK = 3
MOBA_Q_CHUNK = 32
ATTN_Q_BLOCK = 128
D_FF = 5632
RMS_EPS = 1e-6
IN_COLS = 3 * DIFF_WIDTH + 3 * MOBA_WIDTH + 2 * D_MODEL

kernel_name = "hybrid_diffattn_moba_gated_macaron"


def rmsnorm(x, g):
    xf = x.astype(jnp.float32)
    y = xf * lax.rsqrt(jnp.mean(xf * xf, axis=-1, keepdims=True) + RMS_EPS)
    return (y * g.astype(jnp.float32)).astype(x.dtype)


def swiglu(h, w_gu, w_down):
    gate, up = jnp.split(h @ w_gu, 2, axis=-1)
    return (jax.nn.silu(gate) * up) @ w_down


def alibi_slopes(n):
    return jnp.asarray(2.0 ** (-8.0 * np.arange(1, n + 1) / n), dtype=jnp.float32)


def diff_attention(q, k, v, lam, subln_g, lam_init):
    B, S, H, _, dh = q.shape
    q = q.transpose(0, 2, 3, 1, 4)
    k = k.transpose(0, 2, 3, 1, 4)
    v = v.transpose(0, 2, 1, 3)
    nq = S // ATTN_Q_BLOCK
    qb = q.reshape(B, H, 2, nq, ATTN_Q_BLOCK, dh).transpose(3, 0, 1, 2, 4, 5)
    slopes = alibi_slopes(H)
    kpos = jnp.arange(S)
    scale = dh ** -0.5

    def block(args):
        qblk, start = args
        s = jnp.einsum('bhmqd,bhmkd->bhmqk', qblk, k).astype(jnp.float32) * scale
        qpos = start + jnp.arange(ATTN_Q_BLOCK)
        dist = (qpos[:, None] - kpos[None, :]).astype(jnp.float32)
        s = s - (slopes[:, None, None] * dist)[None, :, None]
        s = jnp.where(dist >= 0, s, -jnp.inf)
        p = jax.nn.softmax(s, axis=-1)
        a = p[:, :, 0] - lam * p[:, :, 1]
        return jnp.einsum('bhqk,bhkd->bhqd', a.astype(v.dtype), v)

    starts = jnp.arange(nq, dtype=jnp.int32) * ATTN_Q_BLOCK
    o = lax.map(block, (qb, starts))
    o = o.transpose(1, 0, 3, 2, 4).reshape(B, S, H, 2 * dh)
    o = rmsnorm(o, subln_g) * (1.0 - lam_init)
    return o.reshape(B, S, H * 2 * dh)


def moba_attention(q, k, v):
    B, S, H, dh = q.shape
    nb = -(-S // MOBA_BLOCK)
    pad = nb * MOBA_BLOCK - S
    n_sel = min(MOBA_TOPK, nb - 1)
    scale = dh ** -0.5
    slopes = alibi_slopes(H)
    q = q.transpose(0, 2, 1, 3)
    k = jnp.pad(k.transpose(0, 2, 1, 3), ((0, 0), (0, 0), (0, pad), (0, 0)))
    v = jnp.pad(v.transpose(0, 2, 1, 3), ((0, 0), (0, 0), (0, pad), (0, 0)))
    kb = k.reshape(B, H, nb, MOBA_BLOCK, dh)
    vb = v.reshape(B, H, nb, MOBA_BLOCK, dh)
    kmean = jnp.mean(kb.astype(jnp.float32), axis=3)
    qblk = jnp.arange(S) // MOBA_BLOCK
    nc = S // MOBA_Q_CHUNK
    qc_all = q.reshape(B, H, nc, MOBA_Q_CHUNK, dh).transpose(2, 0, 1, 3, 4)
    starts = jnp.arange(nc, dtype=jnp.int32) * MOBA_Q_CHUNK

    if n_sel > 0:
        gscore = jnp.einsum('bhsd,bhnd->bhsn', q.astype(jnp.float32), kmean)
        past = jnp.arange(nb)[None, :] < qblk[:, None]
        gscore = jnp.where(past, gscore, -jnp.inf)
        _, idx = lax.top_k(gscore, n_sel)
        valid = idx < qblk[:, None]
        idx_all = idx.reshape(B, H, nc, MOBA_Q_CHUNK, n_sel).transpose(2, 0, 1, 3, 4)
        val_all = valid.reshape(B, H, nc, MOBA_Q_CHUNK, n_sel).transpose(2, 0, 1, 3, 4)
    else:
        idx_all = jnp.zeros((nc, B, H, MOBA_Q_CHUNK, 0), jnp.int32)
        val_all = jnp.zeros((nc, B, H, MOBA_Q_CHUNK, 0), bool)

    gather_blocks = jax.vmap(jax.vmap(lambda tbl, ix: tbl[ix]))

    def chunk(args):
        qc, idc, vdc, start = args
        qpos = start + jnp.arange(MOBA_Q_CHUNK)
        own = start // MOBA_BLOCK
        k_own = lax.dynamic_index_in_dim(kb, own, axis=2, keepdims=False)
        v_own = lax.dynamic_index_in_dim(vb, own, axis=2, keepdims=False)
        own_pos = own * MOBA_BLOCK + jnp.arange(MOBA_BLOCK)
        d_own = (qpos[:, None] - own_pos[None, :]).astype(jnp.float32)
        s_own = jnp.einsum('bhqd,bhkd->bhqk', qc, k_own).astype(jnp.float32) * scale
        s_own = jnp.where(d_own >= 0, s_own - slopes[None, :, None, None] * d_own, -jnp.inf)
        if n_sel == 0:
            p = jax.nn.softmax(s_own, axis=-1)
            return jnp.einsum('bhqk,bhkd->bhqd', p.astype(v_own.dtype), v_own)
        k_sel = gather_blocks(kb, idc)
        v_sel = gather_blocks(vb, idc)
        sel_pos = idc[..., None] * MOBA_BLOCK + jnp.arange(MOBA_BLOCK)
        d_sel = (qpos[None, None, :, None, None] - sel_pos).astype(jnp.float32)
        s_sel = jnp.einsum('bhqd,bhqjkd->bhqjk', qc, k_sel).astype(jnp.float32) * scale
        s_sel = s_sel - slopes[None, :, None, None, None] * d_sel
        s_sel = jnp.where(vdc[..., None], s_sel, -jnp.inf)
        Bq, Hq, C = s_own.shape[:3]
        s_all = jnp.concatenate([s_sel.reshape(Bq, Hq, C, n_sel * MOBA_BLOCK), s_own], axis=-1)
        p = jax.nn.softmax(s_all, axis=-1)
        p_sel = p[..., :n_sel * MOBA_BLOCK].reshape(Bq, Hq, C, n_sel, MOBA_BLOCK)
        p_own = p[..., n_sel * MOBA_BLOCK:]
        return (jnp.einsum('bhqjk,bhqjkd->bhqd', p_sel.astype(v_sel.dtype), v_sel)
                + jnp.einsum('bhqk,bhkd->bhqd', p_own.astype(v_own.dtype), v_own))

    o = lax.map(chunk, (qc_all, idx_all, val_all, starts))
    return o.transpose(1, 0, 3, 2, 4).reshape(B, S, H * dh)


def setup_inputs(seed: int = 0) -> dict:
    key = jax.random.key(seed)
    ks = jax.random.split(key, 20)
    f32 = jnp.float32
    L, D = DEPTH, D_MODEL

    def nrm(k, shape, fan_in):
        return jax.random.normal(k, shape, f32) * (fan_in ** -0.5)

    def gain(k, shape):
        return 1.0 + 0.02 * jax.random.normal(k, shape, f32)

    return {
        "x": jax.random.normal(ks[0], (BATCH, SEQ, D), f32),
        "g_ffn1": gain(ks[1], (L, D)),
        "w_ffn1_gu": nrm(ks[2], (L, D, 2 * D_FF), D),
        "w_ffn1_down": nrm(ks[3], (L, D_FF, D), D_FF),
        "g_mix": gain(ks[4], (L, D)),
        "w_in": nrm(ks[5], (L, D, IN_COLS), D),
        "lam_q1": 0.1 * jax.random.normal(ks[6], (L, DIFF_HEAD_DIM), f32),
        "lam_k1": 0.1 * jax.random.normal(ks[7], (L, DIFF_HEAD_DIM), f32),
        "lam_q2": 0.1 * jax.random.normal(ks[8], (L, DIFF_HEAD_DIM), f32),
        "lam_k2": 0.1 * jax.random.normal(ks[9], (L, DIFF_HEAD_DIM), f32),
        "g_subln": gain(ks[10], (L, 2 * DIFF_HEAD_DIM)),
        "p_a": nrm(ks[11], (L, DIFF_WIDTH, D), DIFF_WIDTH),
        "p_b": nrm(ks[12], (L, MOBA_WIDTH, D), MOBA_WIDTH),
        "w_o": nrm(ks[13], (L, D, D), D),
        "g_ffn2": gain(ks[14], (L, D)),
        "w_ffn2_gu": nrm(ks[15], (L, D, 2 * D_FF), D),
        "w_ffn2_down": nrm(ks[16], (L, D_FF, D), D_FF),
        "g_final": gain(ks[17], (D,)),
    }


def reference(x, g_ffn1, w_ffn1_gu, w_ffn1_down, g_mix, w_in, lam_q1, lam_k1, lam_q2, lam_k2,
              g_subln, p_a, p_b, w_o, g_ffn2, w_ffn2_gu, w_ffn2_down, g_final):
    B, S, D = x.shape
    c0 = 0
    offs = []
    for w in (DIFF_WIDTH, DIFF_WIDTH, DIFF_WIDTH, MOBA_WIDTH, MOBA_WIDTH, MOBA_WIDTH, D_MODEL):
        c0 += w
        offs.append(c0)
    for l in range(DEPTH):
        x = x + 0.5 * swiglu(rmsnorm(x, g_ffn1[l]), w_ffn1_gu[l], w_ffn1_down[l])
        h = rmsnorm(x, g_mix[l])
        proj = h @ w_in[l]
        qa, ka, va, qb, kb, vb, gate_a, gate_b = jnp.split(proj, offs, axis=-1)
        qa = qa.reshape(B, S, N_HEADS_DIFF, 2, DIFF_HEAD_DIM)
        ka = ka.reshape(B, S, N_HEADS_DIFF, 2, DIFF_HEAD_DIM)
        va = va.reshape(B, S, N_HEADS_DIFF, 2 * DIFF_HEAD_DIM)
        lam_init = 0.8 - 0.6 * math.exp(-0.3 * l)
        lam = (jnp.exp(jnp.sum(lam_q1[l].astype(jnp.float32) * lam_k1[l].astype(jnp.float32)))
               - jnp.exp(jnp.sum(lam_q2[l].astype(jnp.float32) * lam_k2[l].astype(jnp.float32)))
               + lam_init)
        o_a = diff_attention(qa, ka, va, lam, g_subln[l], lam_init)
        o_b = moba_attention(qb.reshape(B, S, N_HEADS_MOBA, MOBA_HEAD_DIM),
                             kb.reshape(B, S, N_HEADS_MOBA, MOBA_HEAD_DIM),
                             vb.reshape(B, S, N_HEADS_MOBA, MOBA_HEAD_DIM))
        merged = jax.nn.sigmoid(gate_a) * (o_a @ p_a[l]) + jax.nn.sigmoid(gate_b) * (o_b @ p_b[l])
        x = x + merged @ w_o[l]
        x = x + 0.5 * swiglu(rmsnorm(x, g_ffn2[l]), w_ffn2_gu[l], w_ffn2_down[l])
    return rmsnorm(x, g_final)
```

```cpp
#include <hip/hip_runtime.h>
#include <hip/hip_cooperative_groups.h>
#include <cstdio>
#include <cstdint>
#include <cmath>
namespace cg = cooperative_groups;
namespace pg8 {
#define PG8_LAS __attribute__((address_space(3)))
typedef unsigned short bf16_t;
typedef short bf16x8 __attribute__((ext_vector_type(8)));
typedef float f32x4 __attribute__((ext_vector_type(4)));
typedef unsigned u32x4 __attribute__((ext_vector_type(4)));
constexpr int BM = 256, BK = 64, HALF = 128, HTB = HALF * BK * 2  , STAGE_BYTES = 8 * HTB, NXCD = 8, WGM = 8;

__host__ __device__ __forceinline__ int lds_byte(int r, int c) { const int st = (r >> 4) * 2 + (c >> 5), rr = r & 15, cc = c & 31, ob = rr * 64 + cc * 2; return st * 1024 + (ob ^ (((ob >> 9) & 1) << 5)); }
__host__ __device__ __forceinline__ void stage_rc(int b, int& R, int& C) { const int st = b / 1024, sb = b % 1024, swz = sb ^ (((sb >> 9) & 1) << 5); R = (st >> 1) * 16 + swz / 64; C = (st & 1) * 32 + (swz % 64) / 2; }
__host__ __device__ __forceinline__ int perm32(int rho) { const int n = rho >> 4, i = rho & 15; return 8 * (i >> 2) + 4 * n + (i & 3); }

struct Unit { int pm, pn; };
struct Gemm { const bf16_t* A; const bf16_t* Bt; int M, N, K; };

struct StaticOrder {
    int nM, nN, nwg, G, c;
    __host__ __device__ void init(int M, int N, int G_, int c_) { nM = M / BM; nN = N / BM; nwg = nM * nN; G = G_; c = c_; }
    __host__ __device__ bool next(int i, Unit& u) const {
        const long L = (long)i * G + c; if (L >= nwg) return false;
        int wgid = (int)L; { const int q = nwg / NXCD, r = nwg % NXCD, xcd = wgid % NXCD, off = wgid / NXCD; wgid = (xcd < r ? xcd * (q + 1) : r * (q + 1) + (xcd - r) * q) + off; }
        const int nig = WGM * nN, gid = wgid / nig, fm = gid * WGM, gsz = (nM - fm) < WGM ? (nM - fm) : WGM;
        u.pm = fm + ((wgid % nig) % gsz); u.pn = (wgid % nig) / gsz; return true;
    }
    __device__ __forceinline__ void a_ready(const Unit&) const {}
    __device__ __forceinline__ void done(const Unit&) const {}
};


typedef float f32x2 __attribute__((ext_vector_type(2)));
typedef unsigned u32x2 __attribute__((ext_vector_type(2)));
typedef __bf16 bf16x2_t __attribute__((ext_vector_type(2)));
__device__ __forceinline__ unsigned cvt_pk_bf16(float lo, float hi) { f32x2 v = {lo, hi}; bf16x2_t b = __builtin_convertvector(v, bf16x2_t); return __builtin_bit_cast(unsigned, b); }
__device__ __forceinline__ float bf_lo(unsigned u) { return __uint_as_float(u << 16); }
__device__ __forceinline__ float bf_hi(unsigned u) { return __uint_as_float(u & 0xffff0000u); }
constexpr int DMODEL = 2048;
constexpr float RMS_EPS = 1e-6f;
constexpr float LOG2E = 1.4426950408889634f;
__device__ __forceinline__ float row_rstd(const float* ssq, int row) {
    const f32x4* p = (const f32x4*)(ssq + (size_t)row * 32);
    float s = 0.f;
#pragma unroll
    for (int i = 0; i < 8; ++i) { const f32x4 v = p[i]; s += (v[0] + v[1]) + (v[2] + v[3]); }
    return __builtin_amdgcn_rsqf(s * (1.0f / DMODEL) + RMS_EPS);
}
__device__ __forceinline__ void rows_rstd(const float* ssq, int row0, int fq, float scale, float (&rs)[2][4]) {
    f32x4 pa[2][4], pb[2][4];
#pragma unroll
    for (int ai = 0; ai < 2; ++ai)
#pragma unroll
        for (int m = 0; m < 4; ++m) { const f32x4* p = (const f32x4*)(ssq + (size_t)(row0 + ai * HALF + m * 16) * 32 + 8 * fq); pa[ai][m] = p[0]; pb[ai][m] = p[1]; }
#pragma unroll
    for (int ai = 0; ai < 2; ++ai)
#pragma unroll
        for (int m = 0; m < 4; ++m) { const f32x4 a = pa[ai][m], c = pb[ai][m]; float s = ((a[0] + a[1]) + (a[2] + a[3])) + ((c[0] + c[1]) + (c[2] + c[3]));
            s += __shfl_xor(s, 16); s += __shfl_xor(s, 32); rs[ai][m] = __builtin_amdgcn_rsqf(s * (1.0f / DMODEL) + RMS_EPS) * scale; }
}
__device__ __forceinline__ float silu_f(float x) { return x * __builtin_amdgcn_rcpf(1.0f + __builtin_amdgcn_exp2f(-x * LOG2E)); }
__device__ __forceinline__ float sigmoid_f(float x) { return __builtin_amdgcn_rcpf(1.0f + __builtin_amdgcn_exp2f(-x * LOG2E)); }

struct EpiSwiglu {
    static constexpr bool PERM = true, AFTER_DRAIN = false;
    bf16_t* O; int ldo; const float* ssq;
    __device__ __forceinline__ void operator()(const f32x4 (&acc)[2][2][4][2], const Unit& u, int wr, int wc, int fr, int fq) const {
        const int row0 = u.pm * BM + wr * 64 + fr, col0 = u.pn * HALF + wc * 32 + 8 * fq;
        float rs[2][4];
        rows_rstd(ssq, row0, fq, 1.0f, rs);
#pragma unroll
        for (int ai = 0; ai < 2; ++ai)
#pragma unroll
            for (int m = 0; m < 4; ++m) { const int row = row0 + ai * HALF + m * 16; const float r = rs[ai][m];
                const f32x4 g0 = acc[ai][0][m][0] * r, g1 = acc[ai][0][m][1] * r, u0 = acc[ai][1][m][0] * r, u1 = acc[ai][1][m][1] * r;
                u32x4 w;
                w.x = cvt_pk_bf16(silu_f(g0[0]) * u0[0], silu_f(g0[1]) * u0[1]); w.y = cvt_pk_bf16(silu_f(g0[2]) * u0[2], silu_f(g0[3]) * u0[3]);
                w.z = cvt_pk_bf16(silu_f(g1[0]) * u1[0], silu_f(g1[1]) * u1[1]); w.w = cvt_pk_bf16(silu_f(g1[2]) * u1[2], silu_f(g1[3]) * u1[3]);
                *(u32x4*)(O + (size_t)row * ldo + col0) = w; }
    }
};
struct EpiRes {
    static constexpr bool PERM = false, AFTER_DRAIN = false;
    const float* base; float* out; bf16_t* outb; float* ssq_out; float alpha;
    __device__ __forceinline__ void operator()(const f32x4 (&acc)[2][2][4][2], const Unit& u, int wr, int wc, int fr, int fq) const {
        const int row0 = u.pm * BM + wr * 64 + fr, col0 = u.pn * BM + wc * 32 + 4 * fq;
#pragma unroll
        for (int ai = 0; ai < 2; ++ai) {
            f32x4 bs[4][2][2];
#pragma unroll
            for (int m = 0; m < 4; ++m)
#pragma unroll
                for (int bj = 0; bj < 2; ++bj)
#pragma unroll
                    for (int n = 0; n < 2; ++n) bs[m][bj][n] = *(const f32x4*)(base + (size_t)(row0 + ai * HALF + m * 16) * DMODEL + col0 + bj * HALF + n * 16);
#pragma unroll
            for (int m = 0; m < 4; ++m) { const int row = row0 + ai * HALF + m * 16; const size_t off = (size_t)row * DMODEL + col0; float sq = 0.f;
#pragma unroll
                for (int bj = 0; bj < 2; ++bj)
#pragma unroll
                    for (int n = 0; n < 2; ++n) { const size_t o2 = off + bj * HALF + n * 16; const f32x4 o = bs[m][bj][n] + acc[ai][bj][m][n] * alpha;
                        *(f32x4*)(out + o2) = o; sq += (o[0] * o[0] + o[1] * o[1]) + (o[2] * o[2] + o[3] * o[3]);
                        if (outb) { u32x2 w; w.x = cvt_pk_bf16(o[0], o[1]); w.y = cvt_pk_bf16(o[2], o[3]); *(u32x2*)(outb + o2) = w; } }
                sq += __shfl_xor(sq, 16); sq += __shfl_xor(sq, 32);
                if (fq == 0) ssq_out[(size_t)row * 32 + u.pn * 4 + wc] = sq; }
        }
    }
};
struct EpiProj {
    static constexpr bool PERM = true, AFTER_DRAIN = false;
    bf16_t* O; int ldo; const float* ssq; float qa_scale, qb_scale; float* kpart;
    __device__ __forceinline__ void operator()(const f32x4 (&acc)[2][2][4][2], const Unit& u, int wr, int wc, int fr, int fq) const {
        const int row0 = u.pm * BM + wr * 64 + fr, col0 = u.pn * BM + wc * 32 + 8 * fq;
        const bool sig = u.pn >= 16; const float sc = u.pn < 4 ? qa_scale : ((u.pn >= 8 && u.pn < 12) ? qb_scale : 1.0f);
        float rs[2][4];
        rows_rstd(ssq, row0, fq, sc, rs);
#pragma unroll
        for (int ai = 0; ai < 2; ++ai)
#pragma unroll
            for (int m = 0; m < 4; ++m) { const int row = row0 + ai * HALF + m * 16; const float r = rs[ai][m];
#pragma unroll
                for (int bj = 0; bj < 2; ++bj) { f32x4 v0 = acc[ai][bj][m][0] * r, v1 = acc[ai][bj][m][1] * r;
                    if (sig) {
#pragma unroll
                        for (int j = 0; j < 4; ++j) { v0[j] = sigmoid_f(v0[j]); v1[j] = sigmoid_f(v1[j]); } }
                    u32x4 w; w.x = cvt_pk_bf16(v0[0], v0[1]); w.y = cvt_pk_bf16(v0[2], v0[3]); w.z = cvt_pk_bf16(v1[0], v1[1]); w.w = cvt_pk_bf16(v1[2], v1[3]);
                    *(u32x4*)(O + (size_t)row * ldo + col0 + bj * HALF) = w; } }
        if (u.pn >= 12 && u.pn < 16) {
#pragma unroll
            for (int bj = 0; bj < 2; ++bj) { f32x4 s0 = {0.f, 0.f, 0.f, 0.f}, s1 = {0.f, 0.f, 0.f, 0.f};
#pragma unroll
                for (int ai = 0; ai < 2; ++ai)
#pragma unroll
                    for (int m = 0; m < 4; ++m) { s0 += acc[ai][bj][m][0] * rs[ai][m]; s1 += acc[ai][bj][m][1] * rs[ai][m]; }
#pragma unroll
                for (int j = 0; j < 4; ++j) {
#pragma unroll
                    for (int o = 1; o < 16; o <<= 1) { s0[j] += __shfl_xor(s0[j], o); s1[j] += __shfl_xor(s1[j], o); } }
                if (fr == 0) { float* kp = kpart + ((size_t)u.pm * 2 + wr) * 1024 + (col0 - 3072) + bj * HALF; *(f32x4*)kp = s0; *(f32x4*)(kp + 4) = s1; } }
        }
    }
};
struct EpiVt {
    static constexpr bool PERM = true, AFTER_DRAIN = false;
    bf16_t* O; int ldo; const float* ssq;
    __device__ __forceinline__ void operator()(const f32x4 (&acc)[2][2][4][2], const Unit& u, int wr, int wc, int fr, int fq) const {
        const int row0 = u.pm * BM + wr * 64 + fr, col0 = u.pn * BM + wc * 32 + 8 * fq;
        f32x4 rs[2][2];
        {
            const float mine = row_rstd(ssq, u.pn * BM + (fr >> 3) * HALF + wc * 32 + 8 * fq + (fr & 7));
            const int lbase = fq * 16;
#pragma unroll
            for (int bj = 0; bj < 2; ++bj)
#pragma unroll
                for (int n = 0; n < 2; ++n)
#pragma unroll
                    for (int j = 0; j < 4; ++j) rs[bj][n][j] = __shfl(mine, lbase + bj * 8 + n * 4 + j);
        }
#pragma unroll
        for (int ai = 0; ai < 2; ++ai)
#pragma unroll
            for (int m = 0; m < 4; ++m) { const int row = row0 + ai * HALF + m * 16;
#pragma unroll
                for (int bj = 0; bj < 2; ++bj) { const f32x4 v0 = acc[ai][bj][m][0] * rs[bj][0], v1 = acc[ai][bj][m][1] * rs[bj][1];
                    u32x4 w; w.x = cvt_pk_bf16(v0[0], v0[1]); w.y = cvt_pk_bf16(v0[2], v0[3]); w.z = cvt_pk_bf16(v1[0], v1[1]); w.w = cvt_pk_bf16(v1[2], v1[3]);
                    *(u32x4*)(O + (size_t)row * ldo + col0 + bj * HALF) = w; } }
    }
};
template <bool FIRST> struct EpiGate {
    static constexpr bool PERM = true, AFTER_DRAIN = false;
    bf16_t* T; const bf16_t* sig; int ldsig;
    __device__ __forceinline__ void operator()(const f32x4 (&acc)[2][2][4][2], const Unit& u, int wr, int wc, int fr, int fq) const {
        const int row0 = u.pm * BM + wr * 64 + fr, col0 = u.pn * BM + wc * 32 + 8 * fq;
#pragma unroll
        for (int ai = 0; ai < 2; ++ai) {
            u32x4 sg[4][2], tt[4][2];
#pragma unroll
            for (int m = 0; m < 4; ++m)
#pragma unroll
                for (int bj = 0; bj < 2; ++bj) { const int row = row0 + ai * HALF + m * 16, col = col0 + bj * HALF;
                    sg[m][bj] = *(const u32x4*)(sig + (size_t)row * ldsig + col);
                    if (!FIRST) tt[m][bj] = *(const u32x4*)(T + (size_t)row * DMODEL + col); }
#pragma unroll
            for (int m = 0; m < 4; ++m) { const int row = row0 + ai * HALF + m * 16;
#pragma unroll
                for (int bj = 0; bj < 2; ++bj) { const int col = col0 + bj * HALF;
                    const u32x4 s = sg[m][bj];
                    const f32x4 a0 = acc[ai][bj][m][0], a1 = acc[ai][bj][m][1];
                    float v[8];
                    v[0] = bf_lo(s.x) * a0[0]; v[1] = bf_hi(s.x) * a0[1]; v[2] = bf_lo(s.y) * a0[2]; v[3] = bf_hi(s.y) * a0[3];
                    v[4] = bf_lo(s.z) * a1[0]; v[5] = bf_hi(s.z) * a1[1]; v[6] = bf_lo(s.w) * a1[2]; v[7] = bf_hi(s.w) * a1[3];
                    bf16_t* tp = T + (size_t)row * DMODEL + col;
                    if (!FIRST) { const u32x4 t = tt[m][bj];
                        v[0] += bf_lo(t.x); v[1] += bf_hi(t.x); v[2] += bf_lo(t.y); v[3] += bf_hi(t.y); v[4] += bf_lo(t.z); v[5] += bf_hi(t.z); v[6] += bf_lo(t.w); v[7] += bf_hi(t.w); }
                    u32x4 w; w.x = cvt_pk_bf16(v[0], v[1]); w.y = cvt_pk_bf16(v[2], v[3]); w.z = cvt_pk_bf16(v[4], v[5]); w.w = cvt_pk_bf16(v[6], v[7]);
                    *(u32x4*)tp = w; } }
        }
    }
};

struct EpiResNorm {
    static constexpr bool PERM = false, AFTER_DRAIN = true;
    const float* base; float* out; const float* gain; float alpha; float* xs; unsigned* cnt;
    __device__ __forceinline__ void operator()(const f32x4 (&)[2][2][4][2], const Unit&, int, int, int, int) const {}
    __device__ __forceinline__ void fused(f32x4 (&acc)[2][2][4][2], const Unit& u, int wr, int wc, int fr, int fq, PG8_LAS unsigned char* lds, int wid, int lane) const {
        PG8_LAS float* P = (PG8_LAS float*)lds;
        PG8_LAS float* S = (PG8_LAS float*)(lds + 8192);
        const int row0 = u.pm * BM + wr * 64 + fr, col0 = u.pn * BM + wc * 32 + 4 * fq;
#pragma unroll
        for (int ai = 0; ai < 2; ++ai) {
            f32x4 bs[4][2][2];
#pragma unroll
            for (int m = 0; m < 4; ++m)
#pragma unroll
                for (int bj = 0; bj < 2; ++bj)
#pragma unroll
                    for (int n = 0; n < 2; ++n) bs[m][bj][n] = *(const f32x4*)(base + (size_t)(row0 + ai * HALF + m * 16) * DMODEL + col0 + bj * HALF + n * 16);
#pragma unroll
            for (int m = 0; m < 4; ++m) { float sq = 0.f;
#pragma unroll
                for (int bj = 0; bj < 2; ++bj)
#pragma unroll
                    for (int n = 0; n < 2; ++n) { const f32x4 o = bs[m][bj][n] + acc[ai][bj][m][n] * alpha; acc[ai][bj][m][n] = o; sq += (o[0] * o[0] + o[1] * o[1]) + (o[2] * o[2] + o[3] * o[3]); }
                sq += __shfl_xor(sq, 16); sq += __shfl_xor(sq, 32);
                if (fq == 0) P[(ai * HALF + wr * 64 + m * 16 + fr) * 4 + wc] = sq; }
        }
        asm volatile("s_waitcnt lgkmcnt(0)" ::: "memory"); __builtin_amdgcn_s_barrier(); asm volatile("" ::: "memory");
        const int row = wid * 32 + (lane & 31);
        if (lane < 32) { const float t = (P[row * 4 + 0] + P[row * 4 + 1]) + (P[row * 4 + 2] + P[row * 4 + 3]);
            __hip_atomic_store(xs + (size_t)(u.pm * BM + row) * 8 + u.pn, t, __ATOMIC_RELAXED, __HIP_MEMORY_SCOPE_AGENT); }
        asm volatile("s_waitcnt vmcnt(0)" ::: "memory");
        if (lane == 0) __hip_atomic_fetch_add(cnt + 64 * u.pm, 1u, __ATOMIC_RELAXED, __HIP_MEMORY_SCOPE_AGENT);
        if (wid == 0) {
            for (unsigned sp = 0; sp < (1u << 22); ++sp) {
                if ((unsigned)__builtin_amdgcn_readfirstlane(__hip_atomic_load(cnt + 64 * u.pm, __ATOMIC_RELAXED, __HIP_MEMORY_SCOPE_AGENT)) >= 64u) break;
                __builtin_amdgcn_s_sleep(2);
            }
            __builtin_amdgcn_fence(__ATOMIC_ACQUIRE, "agent");
        }
        asm volatile("s_waitcnt vmcnt(0) lgkmcnt(0)" ::: "memory"); __builtin_amdgcn_s_barrier(); asm volatile("" ::: "memory");
        if (lane < 32) { const float* sl = xs + (size_t)(u.pm * BM + row) * 8; float t[8];
#pragma unroll
            for (int i = 0; i < 8; ++i) t[i] = __hip_atomic_load(sl + i, __ATOMIC_RELAXED, __HIP_MEMORY_SCOPE_AGENT);
            const float tot = ((t[0] + t[1]) + (t[2] + t[3])) + ((t[4] + t[5]) + (t[6] + t[7]));
            S[row] = __builtin_amdgcn_rsqf(tot * (1.0f / DMODEL) + RMS_EPS); }
        asm volatile("s_waitcnt lgkmcnt(0)" ::: "memory"); __builtin_amdgcn_s_barrier(); asm volatile("" ::: "memory");
        f32x4 gv[2][2];
#pragma unroll
        for (int bj = 0; bj < 2; ++bj)
#pragma unroll
            for (int n = 0; n < 2; ++n) gv[bj][n] = *(const f32x4*)(gain + col0 + bj * HALF + n * 16);
#pragma unroll
        for (int ai = 0; ai < 2; ++ai)
#pragma unroll
            for (int m = 0; m < 4; ++m) { const int rl = ai * HALF + wr * 64 + m * 16 + fr; const float rs = S[rl]; const size_t off = (size_t)(u.pm * BM + rl) * DMODEL + col0;
#pragma unroll
                for (int bj = 0; bj < 2; ++bj)
#pragma unroll
                    for (int n = 0; n < 2; ++n) *(f32x4*)(out + off + bj * HALF + n * 16) = acc[ai][bj][m][n] * rs * gv[bj][n]; }
    }
};

template <class Epi, class Sched, bool ALIGN_EPI = false, bool SP2 = false>
__device__ __forceinline__ void gemm_phase(PG8_LAS unsigned char* lds, const Gemm g, const Sched& S, const Epi& E) {
    int tid_o = threadIdx.x; asm volatile("" : "+v"(tid_o));
    const int tid = tid_o, wid = __builtin_amdgcn_readfirstlane(tid >> 6), lane = tid & 63, wr = wid >> 2, wc = wid & 3, fr = lane & 15, fq = lane >> 4;
    const int K = g.K, nt = K / BK;
    unsigned voffA[2], voffB[2];
#pragma unroll
    for (int i = 0; i < 2; ++i) { int R, C; stage_rc(tid * 16 + i * 8192, R, C); const int Rb = Epi::PERM ? ((R & ~31) + perm32(R & 31)) : R;
        voffA[i] = (unsigned)(R * K + C) * 2u; voffB[i] = (unsigned)(Rb * K + C) * 2u; }
    const size_t kstep = (size_t)(BK * 2);
    const size_t hstep = (size_t)HALF * K * 2;
    const size_t tstep = 2 * hstep;
    const unsigned ldsw = (unsigned)wid * 1024u;
    const int aoff = lds_byte(wr * 64 + fr, fq * 8), boff = lds_byte(wc * 32 + fr, fq * 8);
#define PG8_SA(b, h) (((b) * 2 + (h)) * HTB)
#define PG8_SB(b, h) ((4 + (b) * 2 + (h)) * HTB)
#define PG8_STAGE(bufoff, gbase, voff) do { _Pragma("unroll") for (int _i = 0; _i < 2; ++_i) \
        __builtin_amdgcn_global_load_lds((const unsigned*)((const char*)(gbase) + (voff)[_i]), (PG8_LAS unsigned*)(lds + (bufoff) + ldsw + _i * 8192), 16, 0, 0); } while (0)
#define PG8_LDA(dst, b, h) do { _Pragma("unroll") for (int m = 0; m < 4; ++m) _Pragma("unroll") for (int k = 0; k < 2; ++k) dst[m][k] = *(const PG8_LAS bf16x8*)(lds + PG8_SA(b, h) + aoff + m * 2048 + k * 1024); } while (0)
#define PG8_LDB(dst, b, h) do { _Pragma("unroll") for (int n = 0; n < 2; ++n) _Pragma("unroll") for (int k = 0; k < 2; ++k) dst[n][k] = *(const PG8_LAS bf16x8*)(lds + PG8_SB(b, h) + boff + n * 2048 + k * 1024); } while (0)
#define PG8_MMA(ai, bj, At, Bt) do { __builtin_amdgcn_s_setprio(1); _Pragma("unroll") for (int m = 0; m < 4; ++m) _Pragma("unroll") for (int n = 0; n < 2; ++n) _Pragma("unroll") for (int k = 0; k < 2; ++k) \
        acc[ai][bj][m][n] = __builtin_amdgcn_mfma_f32_16x16x32_bf16(Bt[n][k], At[m][k], acc[ai][bj][m][n], 0, 0, 0); __builtin_amdgcn_s_setprio(0); } while (0)
#define PG8_WAIT_V(n) asm volatile("s_waitcnt vmcnt(" #n ")" ::: "memory")
#define PG8_WAIT_L(n) asm volatile("s_waitcnt lgkmcnt(" #n ")" ::: "memory")
#define PG8_BAR __builtin_amdgcn_s_barrier()
#define PG8_SCHED __builtin_amdgcn_sched_barrier(0)
    Unit cur, nxt; int ui = 0;
    if (!S.next(0, cur)) return;
    f32x4 acc[2][2][4][2];
#pragma unroll
    for (int a = 0; a < 2; ++a)
#pragma unroll
        for (int b = 0; b < 2; ++b)
#pragma unroll
            for (int m = 0; m < 4; ++m)
#pragma unroll
                for (int n = 0; n < 2; ++n) acc[a][b][m][n] = (f32x4){0.f, 0.f, 0.f, 0.f};
    bf16x8 At[4][2], B0[2][2], B1[2][2];
    const char* cA = (const char*)g.A + (size_t)cur.pm * tstep; const char* cB = (const char*)g.Bt + (size_t)cur.pn * tstep;
    S.a_ready(cur);
    if constexpr (SP2) {
        PG8_STAGE(PG8_SB(0, 0), cB, voffB); PG8_STAGE(PG8_SB(0, 1), cB + hstep, voffB); PG8_STAGE(PG8_SA(0, 0), cA, voffA); PG8_STAGE(PG8_SA(0, 1), cA + hstep, voffA);
        if (wr == 1) PG8_BAR;
        PG8_WAIT_V(2); PG8_BAR;
        PG8_STAGE(PG8_SB(1, 0), cB + kstep, voffB); PG8_STAGE(PG8_SA(1, 0), cA + kstep, voffA); PG8_STAGE(PG8_SB(1, 1), cB + hstep + kstep, voffB);
        PG8_WAIT_V(6); PG8_BAR;
    } else {
        PG8_STAGE(PG8_SB(0, 0), cB, voffB); PG8_STAGE(PG8_SA(0, 0), cA, voffA); PG8_STAGE(PG8_SB(0, 1), cB + hstep, voffB); PG8_STAGE(PG8_SA(0, 1), cA + hstep, voffA);
        if (wr == 1) PG8_BAR;
        PG8_WAIT_V(4); PG8_BAR;
        PG8_STAGE(PG8_SB(1, 0), cB + kstep, voffB); PG8_STAGE(PG8_SA(1, 0), cA + kstep, voffA); PG8_STAGE(PG8_SB(1, 1), cB + hstep + kstep, voffB);
        PG8_WAIT_V(6); PG8_BAR;
    }
    for (;;) {
        const bool has_next = S.next(ui + 1, nxt);
        const char* nA = has_next ? (const char*)g.A + (size_t)nxt.pm * tstep : cA; const char* nB = has_next ? (const char*)g.Bt + (size_t)nxt.pn * tstep : cB;
        for (int t = 0; t < nt; t += 2) {
            const bool last = (t == nt - 2);
            const char* a1 = cA + (size_t)(t + 1) * kstep;
            const char* a2 = last ? nA : cA + (size_t)(t + 2) * kstep; const char* b2 = last ? nB : cB + (size_t)(t + 2) * kstep;
            const char* a3 = a2 + kstep; const char* b3 = b2 + kstep;
            if (last && has_next) S.a_ready(nxt);
            if constexpr (SP2) {
            PG8_LDB(B0, 0, 0); PG8_LDB(B1, 0, 1); PG8_SCHED; PG8_LDA(At, 0, 0); PG8_STAGE(PG8_SA(1, 1), a1 + hstep, voffA);
            PG8_WAIT_V(8); PG8_WAIT_L(0); PG8_BAR; PG8_MMA(0, 0, At, B0); PG8_MMA(0, 1, At, B1); PG8_BAR; PG8_SCHED;
            PG8_LDA(At, 0, 1); PG8_STAGE(PG8_SB(0, 0), b2, voffB); PG8_STAGE(PG8_SB(0, 1), b2 + hstep, voffB); PG8_STAGE(PG8_SA(0, 0), a2, voffA);
            PG8_WAIT_V(8); PG8_WAIT_L(0); PG8_BAR; PG8_MMA(1, 0, At, B0); PG8_MMA(1, 1, At, B1); PG8_BAR; PG8_SCHED;
            PG8_LDB(B0, 1, 0); PG8_LDB(B1, 1, 1); PG8_SCHED; PG8_LDA(At, 1, 0); PG8_STAGE(PG8_SA(0, 1), a2 + hstep, voffA);
            PG8_WAIT_V(8); PG8_WAIT_L(0); PG8_BAR; PG8_MMA(0, 0, At, B0); PG8_MMA(0, 1, At, B1); PG8_BAR; PG8_SCHED;
            PG8_LDA(At, 1, 1); PG8_STAGE(PG8_SB(1, 0), b3, voffB); PG8_STAGE(PG8_SB(1, 1), b3 + hstep, voffB); PG8_STAGE(PG8_SA(1, 0), a3, voffA);
            PG8_WAIT_V(8); PG8_WAIT_L(0); PG8_BAR; PG8_MMA(1, 0, At, B0); PG8_MMA(1, 1, At, B1); PG8_BAR; PG8_SCHED;
            } else {
            PG8_LDB(B0, 0, 0); PG8_SCHED; PG8_LDA(At, 0, 0); PG8_STAGE(PG8_SA(1, 1), a1 + hstep, voffA);
            PG8_WAIT_L(8); PG8_BAR; PG8_WAIT_L(0); PG8_MMA(0, 0, At, B0); PG8_BAR; PG8_SCHED;
            PG8_LDB(B1, 0, 1); PG8_STAGE(PG8_SB(0, 0), b2, voffB);
            PG8_BAR; PG8_WAIT_L(0); PG8_MMA(0, 1, At, B1); PG8_BAR;
            PG8_LDA(At, 0, 1); PG8_STAGE(PG8_SA(0, 0), a2, voffA);
            PG8_BAR; PG8_WAIT_L(0); PG8_MMA(1, 0, At, B0); PG8_BAR; PG8_SCHED;
            PG8_STAGE(PG8_SB(0, 1), b2 + hstep, voffB);
            PG8_WAIT_V(6); PG8_BAR; PG8_MMA(1, 1, At, B1); PG8_BAR;
            PG8_LDB(B0, 1, 0); PG8_SCHED; PG8_LDA(At, 1, 0); PG8_STAGE(PG8_SA(0, 1), a2 + hstep, voffA);
            PG8_WAIT_L(8); PG8_BAR; PG8_WAIT_L(0); PG8_MMA(0, 0, At, B0); PG8_BAR; PG8_SCHED;
            PG8_LDB(B1, 1, 1); PG8_STAGE(PG8_SB(1, 0), b3, voffB);
            PG8_BAR; PG8_WAIT_L(0); PG8_MMA(0, 1, At, B1); PG8_BAR;
            PG8_LDA(At, 1, 1); PG8_STAGE(PG8_SA(1, 0), a3, voffA);
            PG8_BAR; PG8_WAIT_L(0); PG8_MMA(1, 0, At, B0); PG8_BAR; PG8_SCHED;
            PG8_STAGE(PG8_SB(1, 1), b3 + hstep, voffB);
            PG8_WAIT_V(6); PG8_BAR; PG8_MMA(1, 1, At, B1); PG8_BAR;
            }
        }
        if constexpr (ALIGN_EPI) { if (wr == 0) PG8_BAR; }
        if constexpr (!Epi::AFTER_DRAIN) { E(acc, cur, wr, wc, fr, fq); S.done(cur); }
        if (!has_next) break;
#pragma unroll
        for (int a = 0; a < 2; ++a)
#pragma unroll
            for (int b = 0; b < 2; ++b)
#pragma unroll
                for (int m = 0; m < 4; ++m)
#pragma unroll
                    for (int n = 0; n < 2; ++n) acc[a][b][m][n] = (f32x4){0.f, 0.f, 0.f, 0.f};
        cur = nxt; cA = nA; cB = nB; ++ui;
        if constexpr (ALIGN_EPI) { if (wr == 1) PG8_BAR; }
    }
    PG8_WAIT_V(0);
    if constexpr (!ALIGN_EPI) { if (wr == 0) PG8_BAR; }
    PG8_BAR;
    if constexpr (Epi::AFTER_DRAIN) { E.fused(acc, cur, wr, wc, fr, fq, lds, wid, lane); S.done(cur); }
#undef PG8_SA
#undef PG8_SB
#undef PG8_STAGE
#undef PG8_LDA
#undef PG8_LDB
#undef PG8_MMA
#undef PG8_WAIT_V
#undef PG8_WAIT_L
#undef PG8_BAR
#undef PG8_SCHED
}
}

using namespace pg8;
#define LAS __attribute__((address_space(3)))
typedef float f32x16 __attribute__((ext_vector_type(16)));

constexpr int BATCH = 4, SEQ = 2048, M_TOK = BATCH * SEQ, DFF = 5632;
constexpr int PJ_LD = 8192;
constexpr int VT_LD = M_TOK;
constexpr float QA_SCALE = 0.125f * LOG2E, QB_SCALE = 0.08838834764831845f * LOG2E;

constexpr size_t MiB = 1u << 20;
constexpr size_t WS_SSQ0 = 0, WS_SSQ1 = 1 * MiB, WS_SSQ2 = 2 * MiB, WS_SSQ3 = 3 * MiB, WS_KMEAN = 4 * MiB, WS_XS = 4 * MiB + 512 * 1024, WS_BAR = 5 * MiB, BAR_BYTES = 32768;
constexpr size_t WS_WGU = 8 * MiB, WS_WDN = 52 * MiB, WS_WIN = 74 * MiB, WS_WV = 106 * MiB, WS_WPA = 114 * MiB, WS_WPB = 118 * MiB, WS_WO = 122 * MiB;
constexpr size_t WS_XB = 130 * MiB, WS_ACT = 162 * MiB, WS_OA = WS_ACT, WS_OB = WS_ACT + 16 * MiB, WS_PJ = 250 * MiB, WS_VT = 378 * MiB, WS_END = 410 * MiB;
constexpr size_t WS_WGU1 = WS_PJ, WS_WDN1 = WS_PJ + 44 * MiB;

constexpr int TAIL1_EXTRA = 7168;
constexpr int WGU2_EARLY = 3328;
constexpr int LDS_BYTES = 147456;

__device__ __forceinline__ float wave_sum(float v) {
#pragma unroll
    for (int o = 1; o < 64; o <<= 1) v += __shfl_xor(v, o);
    return v;
}
struct ConvDesc { const float* src; bf16_t* dst; const float* g; int Nsrc, K; };
#ifndef CONV_MODE
#define CONV_MODE 1
#endif
__device__ __forceinline__ ConvDesc conv_desc(const float* W, int K, int Nsrc, int c0, int nc, bf16_t* WT, int r0, const float* g, int mode, int item) {
    const int nblk = nc / 64;
    int kb, nb;
    if (CONV_MODE == 0) { kb = item / nblk; nb = item % nblk; }
    else { const int j = item & 7, t = item >> 3; nb = t % nblk; kb = (t / nblk) * 8 + j; }
    const int loc = 64 * nb;
    int dst = r0 + loc;
    if (mode == 1) { const int half = nc / 2; const int l2 = loc < half ? loc : loc - half; dst = r0 + 256 * (l2 / 128) + (l2 % 128) + (loc < half ? 0 : 128); }
    ConvDesc d; d.src = W + (size_t)(64 * kb) * Nsrc + c0 + loc; d.dst = WT + (size_t)dst * K + 64 * kb; d.g = g ? g + 64 * kb : nullptr; d.Nsrc = Nsrc; d.K = K;
    return d;
}
__device__ __forceinline__ void conv_load(const ConvDesc& d, f32x4 (&v)[16], int lane) {
    const int kq = lane >> 4, n4 = (lane & 15) * 4;
    const float* src = d.src + (size_t)(2 * kq) * d.Nsrc + n4;
#pragma unroll
    for (int i = 0; i < 8; ++i) { v[2 * i] = __builtin_nontemporal_load((const f32x4*)(src + (size_t)(8 * i) * d.Nsrc)); v[2 * i + 1] = __builtin_nontemporal_load((const f32x4*)(src + (size_t)(8 * i + 1) * d.Nsrc)); }
}
__device__ __forceinline__ void conv_scatter(const ConvDesc& d, f32x4 (&v)[16], LAS unsigned* scr, int lane) {
    const int kq = lane >> 4, n4 = (lane & 15) * 4;
    if (d.g) {
#pragma unroll
        for (int i = 0; i < 8; ++i) { const f32x2 gg = *(const f32x2*)(d.g + 8 * i + 2 * kq); v[2 * i] = v[2 * i] * gg.x; v[2 * i + 1] = v[2 * i + 1] * gg.y; } }
#pragma unroll
    for (int i = 0; i < 8; ++i)
#pragma unroll
        for (int j = 0; j < 4; ++j) scr[(n4 + j) * 33 + 4 * i + kq] = cvt_pk_bf16(v[2 * i][j], v[2 * i + 1][j]);
}
__device__ __forceinline__ void conv_store(const ConvDesc& d, const LAS unsigned* scr, int lane) {
    const int c = lane & 7, nl = lane >> 3;
#pragma unroll
    for (int jj = 0; jj < 8; ++jj) { const int n = nl + 8 * jj; const LAS unsigned* sp = scr + n * 33 + 4 * c;
        u32x4 o; o.x = sp[0]; o.y = sp[1]; o.z = sp[2]; o.w = sp[3];
        *(u32x4*)(d.dst + (size_t)n * d.K + 8 * c) = o; }
}
__device__ __forceinline__ void conv_pair(const ConvDesc& A, const ConvDesc& B, bool hasB, LAS unsigned* scr, int lane) {
    f32x4 va[16], vb[16];
    conv_load(A, va, lane);
    if (hasB) conv_load(B, vb, lane);
    conv_scatter(A, va, scr, lane);
    if (hasB) conv_scatter(B, vb, scr + 2112, lane);
    asm volatile("s_waitcnt lgkmcnt(0)" ::: "memory");
    conv_store(A, scr, lane);
    if (hasB) conv_store(B, scr + 2112, lane);
    asm volatile("s_waitcnt lgkmcnt(0)" ::: "memory");
}

constexpr int ATT_KPMAX = 272, ATT_VP = 144;
constexpr int ATT_LDS_KB = 64 * ATT_KPMAX, ATT_LDS_V0 = 2 * ATT_LDS_KB, ATT_LDS_VB = 128 * ATT_VP;
constexpr float ATT_NEG = -1e30f;
#define MFMA32(a, b, c) __builtin_amdgcn_mfma_f32_32x32x16_bf16((a), (b), (c), 0, 0, 0)

template <int DH, bool MOBA>
__device__ __forceinline__ void flash_pass(LAS unsigned char* lds, const bf16_t* qrow, const bf16_t* kbase, const bf16_t* vtbase, int q0, int qblk, float sl2, unsigned sel, f32x16 (&o)[4], int tid) {
    const int lane = tid & 63, r32 = lane & 31, hi = lane >> 5, wid = __builtin_amdgcn_readfirstlane(tid >> 6);
    constexpr int KP = DH * 2 + 16, KPIECES = DH / 8, KLD = (64 * KPIECES) / 512;
    bf16x8 qf[DH / 16];
#pragma unroll
    for (int d0 = 0; d0 < DH / 16; ++d0) qf[d0] = *(const bf16x8*)(qrow + d0 * 16 + hi * 8);
    const int qw0 = q0 + wid * 32, qpos = qw0 + r32;
    float m_run = 0.f, l_run = 0.f;
#pragma unroll
    for (int d = 0; d < 4; ++d)
#pragma unroll
        for (int r = 0; r < 16; ++r) o[d][r] = 0.f;
    const int NT = 4 * (qblk + 1);
    const int pg = r32 >> 3, phh = (r32 >> 2) & 1, pt = r32 & 3, prow = 16 * (pg >> 1) + 8 * phh + 4 * (pg & 1) + pt;
    const unsigned kfo = prow * KP + hi * 16, vfo = r32 * ATT_VP + hi * 16;
    u32x4 kreg[KLD], vreg[2];
#define TILE_OF(i) (MOBA ? ((((i) < 4) ? qblk : (((i) >> 2) - 1)) * 4 + ((i) & 3)) : (i))
#define LOADG(tile) do { const int kv0_ = (tile) * 64; \
        _Pragma("unroll") for (int j = 0; j < KLD; ++j) { const int p = tid + 512 * j, row = p / KPIECES, c = p % KPIECES; kreg[j] = *(const u32x4*)(kbase + (size_t)(kv0_ + row) * PJ_LD + c * 8); } \
        _Pragma("unroll") for (int j = 0; j < 2; ++j) { const int p = tid + 512 * j, d = p >> 3, c = p & 7; vreg[j] = *(const u32x4*)(vtbase + (size_t)d * VT_LD + kv0_ + c * 8); } } while (0)
#define STORE_LDS(buf) do { \
        _Pragma("unroll") for (int j = 0; j < KLD; ++j) { const int p = tid + 512 * j, row = p / KPIECES, c = p % KPIECES; *(LAS u32x4*)(lds + (buf) * ATT_LDS_KB + row * KP + c * 16) = kreg[j]; } \
        _Pragma("unroll") for (int j = 0; j < 2; ++j) { const int p = tid + 512 * j, d = p >> 3, c = p & 7; *(LAS u32x4*)(lds + ATT_LDS_V0 + (buf) * ATT_LDS_VB + d * ATT_VP + c * 16) = vreg[j]; } } while (0)
    LOADG(TILE_OF(0)); STORE_LDS(0); __syncthreads();
#pragma unroll 1
    for (int i = 0; i < NT; ++i) {
        const int tile = TILE_OF(i), kv0 = tile * 64, blk = tile >> 2, buf = i & 1;
        { const int in_ = (i + 1 < NT) ? i + 1 : i; LOADG(TILE_OF(in_)); }
        const bool diag = (blk == qblk);
        bool active = !(diag && kv0 > qw0 + 31);
        const bool mysel = MOBA ? (((sel >> blk) & 1u) != 0u) : true;
        if (MOBA && !diag) { if (!__any(mysel ? 1 : 0)) active = false; }
        if (active) {
            const LAS unsigned char* Kb = lds + buf * ATT_LDS_KB; const LAS unsigned char* Vb = lds + ATT_LDS_V0 + buf * ATT_LDS_VB;
            f32x16 s[2];
            const float fb = sl2 * (float)(kv0 + 8 * hi - qpos) - m_run;
            const int thr = qpos - kv0 - 8 * hi;
            const bool need = (diag && kv0 + 63 > qw0) || (MOBA && !diag && !__all(mysel ? 1 : 0));
            int thr_eff = diag ? thr : 4096;
            if (MOBA) thr_eff = (!diag && !mysel) ? -4096 : thr_eff;
            constexpr int NQK = DH / 16, PER = 16 / NQK;
            {
                const float fb0 = fb, fb1 = fb + sl2 * 16.0f;
#pragma unroll
                for (int r = 0; r < 16; ++r) s[0][r] = ((r >> 3) ? fb1 : fb0) + sl2 * (float)(r & 7);
            }
            const float fb2 = fb + sl2 * 32.0f, fb3 = fb + sl2 * 48.0f;
            __builtin_amdgcn_s_setprio(1);
#pragma unroll
            for (int g0 = 0; g0 < NQK; g0 += 4) {
                bf16x8 kf[4];
#pragma unroll
                for (int j4 = 0; j4 < 4; ++j4) kf[j4] = *(const LAS bf16x8*)(Kb + kfo + (g0 + j4) * 32);
#pragma unroll
                for (int j4 = 0; j4 < 4; ++j4) { const int d0 = g0 + j4;
                    s[0] = MFMA32(kf[j4], qf[d0], s[0]);
#pragma unroll
                    for (int j = 0; j < PER; ++j) { const int r = d0 * PER + j; s[1][r] = ((r >> 3) ? fb3 : fb2) + sl2 * (float)(r & 7); }
                }
                __builtin_amdgcn_sched_barrier(0);
            }
            __builtin_amdgcn_s_setprio(0);
            if (need) {
#pragma unroll
                for (int r = 0; r < 16; ++r) s[0][r] = (16 * (r >> 3) + (r & 7) > thr_eff) ? ATT_NEG : s[0][r];
            }
            float mx = fmaxf(fmaxf(s[0][0], s[0][1]), s[0][2]);
#pragma unroll
            for (int r = 3; r < 15; r += 2) mx = fmaxf(fmaxf(mx, s[0][r]), s[0][r + 1]);
            mx = fmaxf(mx, s[0][15]);
            __builtin_amdgcn_sched_barrier(0);
            __builtin_amdgcn_s_setprio(1);
#pragma unroll
            for (int g0 = 0; g0 < NQK; g0 += 4) {
                bf16x8 kf[4];
#pragma unroll
                for (int j4 = 0; j4 < 4; ++j4) kf[j4] = *(const LAS bf16x8*)(Kb + kfo + 32 * KP + (g0 + j4) * 32);
#pragma unroll
                for (int j4 = 0; j4 < 4; ++j4) { const int d0 = g0 + j4;
                    s[1] = MFMA32(kf[j4], qf[d0], s[1]);
#pragma unroll
                    for (int j = 0; j < PER; ++j) { const int r = d0 * PER + j; s[0][r] = __builtin_amdgcn_exp2f(s[0][r]); asm volatile("" : "+v"(s[0][r])); }
                    __builtin_amdgcn_sched_barrier(0);
                }
            }
            __builtin_amdgcn_s_setprio(0);
            if (need) {
#pragma unroll
                for (int r = 0; r < 16; ++r) s[1][r] = (32 + 16 * (r >> 3) + (r & 7) > thr_eff) ? ATT_NEG : s[1][r];
            }
            mx = fmaxf(fmaxf(mx, s[1][0]), s[1][1]);
#pragma unroll
            for (int r = 2; r < 16; r += 2) mx = fmaxf(fmaxf(mx, s[1][r]), s[1][r + 1]);
            mx = fmaxf(mx, __shfl_xor(mx, 32));
            if (__any(mx > 8.0f ? 1 : 0)) {
                const float dl = fmaxf(mx, 0.f), alpha = __builtin_amdgcn_exp2f(-dl);
                m_run += dl; l_run *= alpha;
#pragma unroll
                for (int d = 0; d < 4; ++d)
#pragma unroll
                    for (int r = 0; r < 16; ++r) o[d][r] *= alpha;
#pragma unroll
                for (int r = 0; r < 16; ++r) { s[0][r] *= alpha; s[1][r] -= dl; }
            }
#define PACK8(S, B) __builtin_bit_cast(bf16x8, (u32x4){cvt_pk_bf16(S[B], S[B + 1]), cvt_pk_bf16(S[B + 2], S[B + 3]), cvt_pk_bf16(S[B + 4], S[B + 5]), cvt_pk_bf16(S[B + 6], S[B + 7])})
            float lsum = 0.f;
#pragma unroll
            for (int r = 0; r < 16; ++r) lsum += s[0][r];
            bf16x8 pb[4];
            pb[0] = PACK8(s[0], 0); pb[1] = PACK8(s[0], 8);
            __builtin_amdgcn_sched_barrier(0);
            __builtin_amdgcn_s_setprio(1);
#pragma unroll
            for (int c = 0; c < 2; ++c) {
                bf16x8 vf[4];
#pragma unroll
                for (int d = 0; d < 4; ++d) vf[d] = *(const LAS bf16x8*)(Vb + vfo + d * 32 * ATT_VP + c * 32);
#pragma unroll
                for (int d = 0; d < 4; ++d) { o[d] = MFMA32(vf[d], pb[c], o[d]);
                    s[1][(c * 4 + d) * 2] = __builtin_amdgcn_exp2f(s[1][(c * 4 + d) * 2]); s[1][(c * 4 + d) * 2 + 1] = __builtin_amdgcn_exp2f(s[1][(c * 4 + d) * 2 + 1]);
                    __builtin_amdgcn_sched_barrier(0); }
            }
            pb[2] = PACK8(s[1], 0); pb[3] = PACK8(s[1], 8);
            __builtin_amdgcn_sched_barrier(0);
#pragma unroll
            for (int c = 2; c < 4; ++c) {
                bf16x8 vf[4];
#pragma unroll
                for (int d = 0; d < 4; ++d) vf[d] = *(const LAS bf16x8*)(Vb + vfo + d * 32 * ATT_VP + c * 32);
#pragma unroll
                for (int d = 0; d < 4; ++d) { o[d] = MFMA32(vf[d], pb[c], o[d]);
                    lsum += s[1][((c - 2) * 4 + d) * 2] + s[1][((c - 2) * 4 + d) * 2 + 1];
                    __builtin_amdgcn_sched_barrier(0); }
            }
            __builtin_amdgcn_s_setprio(0);
            l_run += lsum;
#undef PACK8
        }
        STORE_LDS((i + 1) & 1);
        __syncthreads();
    }
#undef TILE_OF
#undef LOADG
#undef STORE_LDS
    const float lt = l_run + __shfl_xor(l_run, 32), inv = 1.0f / lt;
#pragma unroll
    for (int d = 0; d < 4; ++d)
#pragma unroll
        for (int r = 0; r < 16; ++r) o[d][r] *= inv;
}

#define XB_TMO      128
#define XB_XCNT(j)  (256  + 64 * (j))
#define XB_XSUB(j)  (1280 + 64 * (j))
#define XB_XGEN(j)  (2304 + 64 * (j))
#define XB_TOP      3328
#define XB_TOPGEN   3392
#define XCD_BAR_WORDS 3456
#define XB_SPIN_CAP (1u << 18)

__device__ __forceinline__ unsigned xb_ld(unsigned* p)              { return __hip_atomic_load(p, __ATOMIC_RELAXED, __HIP_MEMORY_SCOPE_AGENT); }
__device__ __forceinline__ unsigned xb_add(unsigned* p, unsigned v) { return __hip_atomic_fetch_add(p, v, __ATOMIC_RELAXED, __HIP_MEMORY_SCOPE_AGENT); }
__device__ __forceinline__ unsigned xb_xcc_id() { return (unsigned)__builtin_amdgcn_s_getreg((3 << 11) | 20) & 0xFu; }
#define XB_SPIN(cond, bar) do { unsigned _sp = 0; while (cond) { __builtin_amdgcn_s_sleep(1); \
    if ((++_sp & 255u) == 0u) { if (xb_ld(&(bar)[XB_TMO])) break; if (_sp > XB_SPIN_CAP) { atomicAdd(&(bar)[XB_TMO], 1u); break; } } } } while (0)

struct XcdBarrier {
    unsigned* bar; unsigned x;
    volatile LAS unsigned* st;
};

__device__ __forceinline__ XcdBarrier xcd_barrier_post(unsigned* bar, volatile LAS unsigned* st) {
    XcdBarrier b; b.bar = bar; b.x = xb_xcc_id(); b.st = st;
    if (threadIdx.x == 0) (void)xb_add(&bar[XB_XCNT(b.x)], 1u);
    return b;
}
__device__ __forceinline__ void xcd_barrier_complete(unsigned* bar, unsigned x, unsigned& nloc, unsigned& nx) {
    const unsigned G = gridDim.x * gridDim.y * gridDim.z;
    unsigned sum, cnt, mine, sp = 0u;
    for (;;) {
        sum = 0u; cnt = 0u; mine = 0u;
#pragma unroll
        for (unsigned j = 0; j < 16; ++j) { const unsigned c = xb_ld(&bar[XB_XCNT(j)]); sum += c; cnt += (c > 0u) ? 1u : 0u; mine = (j == x) ? c : mine; }
        if (sum == G) break;
        __builtin_amdgcn_s_sleep(1);
        if ((++sp & 255u) == 0u) { if (xb_ld(&bar[XB_TMO])) break; if (sp > XB_SPIN_CAP) { atomicAdd(&bar[XB_TMO], 1u); break; } }
    }
    nloc = mine > 0u ? mine : 1u; nx = cnt > 0u ? cnt : 1u;
}

__device__ __forceinline__ void xcd_barrier(const XcdBarrier& b) {
    asm volatile("s_waitcnt vmcnt(0)" ::: "memory");
    __syncthreads();
    if (threadIdx.x == 0) {
        unsigned* bar = b.bar;
        __builtin_amdgcn_s_waitcnt(0);
        unsigned nloc = b.st[0], nx = b.st[1];
        if (nloc == 0u) { xcd_barrier_complete(bar, b.x, nloc, nx); b.st[0] = nloc; b.st[1] = nx; }
        const unsigned old = xb_add(&bar[XB_XSUB(b.x)], 1u);
        const unsigned gen = old / nloc;
        if (old + 1u == (gen + 1u) * nloc) {
            __builtin_amdgcn_fence(__ATOMIC_RELEASE, "agent");
            asm volatile("s_waitcnt vmcnt(0)" ::: "memory");
            const unsigned og = xb_add(&bar[XB_TOP], 1u);
            const unsigned tg = og / nx;
            if (og + 1u == (tg + 1u) * nx) xb_add(&bar[XB_TOPGEN], 1u);
            else XB_SPIN(xb_ld(&bar[XB_TOPGEN]) == tg, bar);
            __builtin_amdgcn_fence(__ATOMIC_ACQUIRE, "agent");
            xb_add(&bar[XB_XGEN(b.x)], 1u);
            asm volatile("s_waitcnt vmcnt(0)" ::: "memory");
        } else {
            XB_SPIN(xb_ld(&bar[XB_XGEN(b.x)]) == gen, bar);
            __builtin_amdgcn_fence(__ATOMIC_ACQUIRE, "agent");
            asm volatile("s_waitcnt vmcnt(0)" ::: "memory");
        }
    }
    __syncthreads();
}

#ifndef PHASES
#define PHASES 0xFFFF
#endif
#ifndef DUP_MASK
#define DUP_MASK 0
#endif
#define REP(bit) _Pragma("unroll 1") for (int rep_ = 0; rep_ < 1 + ((DUP_MASK >> (bit)) & 1); ++rep_)
struct Args { const float* in[18]; float* out; unsigned char* ws; };

__global__ void __launch_bounds__(512, 2) mega_fwd(Args a) {
    extern __shared__ __attribute__((aligned(16))) unsigned char lds_raw[];
    LAS unsigned char* lds = (LAS unsigned char*)lds_raw;
    cg::grid_group grid = cg::this_grid();
    const int G = gridDim.x, NGW = G * 8;
    volatile LAS unsigned* bar_st = (volatile LAS unsigned*)(lds + LDS_BYTES - 64);
    if (threadIdx.x < 2) bar_st[threadIdx.x] = 0u;
    __syncthreads();
    const XcdBarrier xbar = xcd_barrier_post((unsigned*)(a.ws + WS_BAR), bar_st);
#define SEAM() xcd_barrier(xbar)
    if (a.out == nullptr) grid.sync();
#define PHASE_IDS() int tid_o = threadIdx.x; asm volatile("" : "+v"(tid_o)); const int tid = tid_o, lane = tid & 63, wave = __builtin_amdgcn_readfirstlane(tid >> 6), gw = blockIdx.x * 8 + wave; \
    LAS unsigned* scr = (LAS unsigned*)(lds + wave * 16896); (void)tid; (void)lane; (void)gw; (void)scr;
    unsigned char* ws = a.ws;
    float* SSQ0 = (float*)(ws + WS_SSQ0); float* SSQ1 = (float*)(ws + WS_SSQ1); float* SSQ2 = (float*)(ws + WS_SSQ2); float* SSQ3 = (float*)(ws + WS_SSQ3);
    float* KMEAN = (float*)(ws + WS_KMEAN);
    bf16_t* WGU = (bf16_t*)(ws + WS_WGU); bf16_t* WDN = (bf16_t*)(ws + WS_WDN); bf16_t* WGU1 = (bf16_t*)(ws + WS_WGU1); bf16_t* WDN1 = (bf16_t*)(ws + WS_WDN1); bf16_t* WIN = (bf16_t*)(ws + WS_WIN); bf16_t* WV = (bf16_t*)(ws + WS_WV);
    bf16_t* WPA = (bf16_t*)(ws + WS_WPA); bf16_t* WPB = (bf16_t*)(ws + WS_WPB); bf16_t* WO = (bf16_t*)(ws + WS_WO);
    bf16_t* XB = (bf16_t*)(ws + WS_XB); bf16_t* ACT = (bf16_t*)(ws + WS_ACT); bf16_t* OA = (bf16_t*)(ws + WS_OA); bf16_t* OB = (bf16_t*)(ws + WS_OB);
    bf16_t* PJ = (bf16_t*)(ws + WS_PJ); bf16_t* VT = (bf16_t*)(ws + WS_VT); bf16_t* MG = VT;
    float* STASH = (float*)(ws + WS_ACT + 32 * MiB);
    float* XR = a.out;

    if (PHASES & (1 << 0)) REP(0)
    {
        PHASE_IDS();
        constexpr int NI = 5632 + 1024 + 1024 + 2048 + 512 + 512 + 512 + 512 + 1024 + WGU2_EARLY;
#define P0_DESC(it_, D) do { int r = (it_); const float* W; int K, Nsrc, c0, nc, r0 = 0, mode = 0; bf16_t* WT; const float* g = nullptr; \
            if (r < 5632) { W = a.in[2]; K = 2048; Nsrc = 11264; c0 = 0; nc = 11264; WT = WGU1; g = a.in[1]; mode = 1; } \
            else if ((r -= 5632) < 1024) { W = a.in[5]; K = 2048; Nsrc = 10240; c0 = 0; nc = 2048; WT = WIN; r0 = 0; g = a.in[4]; } \
            else if ((r -= 1024) < 1024) { W = a.in[5]; K = 2048; Nsrc = 10240; c0 = 3072; nc = 2048; WT = WIN; r0 = 2048; g = a.in[4]; } \
            else if ((r -= 1024) < 2048) { W = a.in[5]; K = 2048; Nsrc = 10240; c0 = 6144; nc = 4096; WT = WIN; r0 = 4096; g = a.in[4]; } \
            else if ((r -= 2048) < 512) { W = a.in[5]; K = 2048; Nsrc = 10240; c0 = 2048; nc = 1024; WT = WV; r0 = 0; g = a.in[4]; } \
            else if ((r -= 512) < 512) { W = a.in[5]; K = 2048; Nsrc = 10240; c0 = 5120; nc = 1024; WT = WV; r0 = 1024; g = a.in[4]; } \
            else if ((r -= 512) < 512) { W = a.in[11]; K = 1024; Nsrc = 2048; c0 = 0; nc = 2048; WT = WPA; } \
            else if ((r -= 512) < 512) { W = a.in[12]; K = 1024; Nsrc = 2048; c0 = 0; nc = 2048; WT = WPB; } \
            else if ((r -= 512) < 1024) { W = a.in[13]; K = 2048; Nsrc = 2048; c0 = 0; nc = 2048; WT = WO; } \
            else { r -= 1024; W = a.in[15]; K = 2048; Nsrc = 11264; c0 = 0; nc = 11264; WT = WGU; g = a.in[14]; mode = 1; } \
            D = conv_desc(W, K, Nsrc, c0, nc, WT, r0, g, mode, r); } while (0)
        const bool skip_late = (G == 256);
        for (int it = gw; it < NI - (skip_late ? 7168 : 0); it += NGW) {
            ConvDesc A; P0_DESC(!skip_late ? it : (it < 5632 ? it : it + 7168), A);
            conv_pair(A, A, false, scr, lane);
        }
#undef P0_DESC
        const float* x = a.in[0];
        for (int row = gw; row < M_TOK; row += NGW) {
            const f32x4* xr = (const f32x4*)(x + (size_t)row * DMODEL) + lane; float s = 0.f;
            u32x2* ob = (u32x2*)(XB + (size_t)row * DMODEL) + lane;
            f32x4 xv[8];
#pragma unroll
            for (int j = 0; j < 8; ++j) xv[j] = __builtin_nontemporal_load(xr + 64 * j);
#pragma unroll
            for (int j = 0; j < 8; ++j) { const f32x4 v = xv[j]; s += (v[0] * v[0] + v[1] * v[1]) + (v[2] * v[2] + v[3] * v[3]); u32x2 w; w.x = cvt_pk_bf16(v[0], v[1]); w.y = cvt_pk_bf16(v[2], v[3]); ob[64 * j] = w; }
            s = wave_sum(s);
            if (lane < 32) SSQ0[(size_t)row * 32 + lane] = (lane == 0) ? s : 0.f;
        }
    }
    SEAM();

    if (PHASES & (1 << 1)) REP(1)
    {
    { Gemm g{XB, WGU1, M_TOK, 2 * DFF, DMODEL}; StaticOrder S; S.init(M_TOK, 2 * DFF, G, (int)blockIdx.x); EpiSwiglu E{ACT, DFF, SSQ0};
      gemm_phase<EpiSwiglu, StaticOrder, true, true>(lds, g, S, E); }
    {
        PHASE_IDS();
        const int nwg = (M_TOK / 256) * (2 * DFF / 256), rounds = (nwg + G - 1) / G, rem = nwg - (rounds - 1) * G;
        int first = gw, stride = NGW;
        if (rem < G) { first = ((int)blockIdx.x - rem) * 8 + wave; stride = (G - rem) * 8; if ((int)blockIdx.x < rem) first = 1 << 30; }
#define T1_DESC(it_, D) do { if ((it_) < 2816) D = conv_desc(a.in[3], 5632, 2048, 0, 2048, WDN1, 0, nullptr, 0, (it_)); \
            else if (G != 256) D = conv_desc(a.in[15], 2048, 11264, 0, 11264, WGU, 0, a.in[14], 1, (it_) - 2816 + WGU2_EARLY); \
            else if ((it_) < 2816 + 512) D = conv_desc(a.in[11], 1024, 2048, 0, 2048, WPA, 0, nullptr, 0, (it_) - 2816); \
            else if ((it_) < 2816 + 1024) D = conv_desc(a.in[12], 1024, 2048, 0, 2048, WPB, 0, nullptr, 0, (it_) - 2816 - 512); \
            else if ((it_) < 2816 + 2048) D = conv_desc(a.in[13], 2048, 2048, 0, 2048, WO, 0, nullptr, 0, (it_) - 2816 - 1024); \
            else if ((it_) < 2816 + 4096) D = conv_desc(a.in[5], 2048, 10240, 6144, 4096, WIN, 4096, a.in[4], 0, (it_) - 2816 - 2048); \
            else if ((it_) < 2816 + 5120) D = conv_desc(a.in[5], 2048, 10240, 0, 2048, WIN, 0, a.in[4], 0, (it_) - 2816 - 4096); \
            else if ((it_) < 2816 + 6144) D = conv_desc(a.in[5], 2048, 10240, 3072, 2048, WIN, 2048, a.in[4], 0, (it_) - 2816 - 5120); \
            else if ((it_) < 2816 + 6656) D = conv_desc(a.in[5], 2048, 10240, 2048, 1024, WV, 0, a.in[4], 0, (it_) - 2816 - 6144); \
            else D = conv_desc(a.in[5], 2048, 10240, 5120, 1024, WV, 1024, a.in[4], 0, (it_) - 2816 - 6656); } while (0)
        for (int it = first; it < (G == 256 ? 2816 + TAIL1_EXTRA : 2816 + 5632 - WGU2_EARLY); it += stride) {
            ConvDesc A; T1_DESC(it, A);
            conv_pair(A, A, false, scr, lane);
        }
#undef T1_DESC
        __syncthreads();
    }
    }
    SEAM();
    if ((DUP_MASK >> 17) & 1) { _Pragma("unroll 1") for (int q = 0; q < 20; ++q) SEAM(); }
    if (PHASES & (1 << 2)) REP(2)
    { Gemm g{ACT, WDN1, M_TOK, DMODEL, DFF}; StaticOrder S; S.init(M_TOK, DMODEL, G, (int)blockIdx.x); EpiRes E{a.in[0], XR, XB, SSQ1, 0.5f};
      gemm_phase<EpiRes, StaticOrder, true, true>(lds, g, S, E); }
    SEAM();
    if (PHASES & (1 << 3)) REP(3)
    {
    { Gemm g{XB, WIN, M_TOK, PJ_LD, DMODEL}; StaticOrder S; S.init(M_TOK, PJ_LD, G, (int)blockIdx.x); EpiProj E{PJ, PJ_LD, SSQ1, QA_SCALE, QB_SCALE, KMEAN};
      gemm_phase<EpiProj, StaticOrder, true, true>(lds, g, S, E); }
    { Gemm g{WV, XB, 2048, M_TOK, DMODEL}; StaticOrder S; S.init(2048, M_TOK, G, (int)blockIdx.x); EpiVt E{VT, VT_LD, SSQ1};
      gemm_phase<EpiVt, StaticOrder, true, true>(lds, g, S, E); }
    }
    SEAM();
    if (PHASES & (1 << 5)) REP(5)
    {
        float lam;
        { int l_o = threadIdx.x; asm volatile("" : "+v"(l_o)); const int lane = l_o & 63; const float p1 = wave_sum(a.in[6][lane] * a.in[7][lane]), p2 = wave_sum(a.in[8][lane] * a.in[9][lane]); lam = __uint_as_float(__builtin_amdgcn_readfirstlane(__float_as_uint(expf(p1) - expf(p2) + 0.2f))); }
        unsigned* cnt_u = (unsigned*)(a.ws + WS_BAR) + 3600; unsigned* cnt_c = (unsigned*)(a.ws + WS_BAR) + 3968;
        volatile LAS unsigned* wq = (volatile LAS unsigned*)(lds + LDS_BYTES - 128);
        const int xq = (int)(blockIdx.x & 7);
#ifndef ATT_DYNAMIC
#define ATT_DYNAMIC 0
#endif
#pragma unroll 1
        for (int ustat = blockIdx.x;; ustat += G) {
            int ucode, useq;
            if (ATT_DYNAMIC) {
                __syncthreads();
                if (threadIdx.x == 0) wq[0] = __hip_atomic_fetch_add(cnt_u + 16 * xq, 1u, __ATOMIC_RELAXED, __HIP_MEMORY_SCOPE_AGENT);
                __syncthreads();
                const int useq8 = __builtin_amdgcn_readfirstlane((int)wq[0]);
                if (useq8 >= 64) break;
                ucode = (int)((0x809A1B2CD3E4F567ull >> (4 * (useq8 >> 2))) & 15ull);
                useq = (useq8 & 3) * 8 + xq;
            } else {
                if (G == 256) {
                    const int k = (int)blockIdx.x >> 5, ui = (ustat - (int)blockIdx.x) >> 8;
                    const int nu = (k == 0) ? 1 : (k == 7 ? 3 : 2);
                    if (ui >= nu * (1 + ((DUP_MASK >> 16) & 1))) break;
                    const unsigned codes = (k == 0) ? 0x007u : (k == 1) ? 0x006u : (k == 2) ? 0x015u : (k == 3) ? 0x024u : (k == 4) ? 0x0D3u : (k == 5) ? 0x0BFu : (k == 6) ? 0x0CEu : 0x89Au;
                    ucode = (int)((codes >> (4 * (ui % nu))) & 15u); useq = (int)blockIdx.x & 31;
                } else {
                if (ustat >= 512 * (1 + ((DUP_MASK >> 16) & 1))) break;
                const int us = ustat & 511;
                useq = us & 31; ucode = us < 256 ? (us >> 5) : (8 | (7 - ((us - 256) >> 5)));
                }
            }
            int tid_o = threadIdx.x; asm volatile("" : "+v"(tid_o));
            const int tid = tid_o, lane = tid & 63, r32 = lane & 31, hi = lane >> 5, wave = __builtin_amdgcn_readfirstlane(tid >> 6);
#ifndef TEST_ATT
#define TEST_ATT 3
#endif
            if (ucode < 8) { if (TEST_ATT & 1) {
                const int qblk = ucode & 7, bh = useq & 31, b = bh >> 3, h = bh & 7, q0 = qblk * 256;
                const float sl2 = exp2f(-(float)(h + 1)) * LOG2E;
                const size_t row = (size_t)b * SEQ + q0 + wave * 32 + r32;
                f32x16 o[4];
                f32x4* stash = (f32x4*)(STASH + ((size_t)blockIdx.x * 512 + tid) * 64);
#pragma unroll 1
                for (int mp = 0; mp < 2; ++mp) {
                    flash_pass<64, false>(lds, PJ + row * PJ_LD + h * 128 + mp * 64, PJ + (size_t)b * SEQ * PJ_LD + 1024 + h * 128 + mp * 64, VT + (size_t)(h * 128) * VT_LD + (size_t)b * SEQ, q0, qblk, sl2, 0u, o, tid);
                    if (mp == 0) {
#pragma unroll
                        for (int d = 0; d < 4; ++d)
#pragma unroll
                            for (int g4 = 0; g4 < 4; ++g4) stash[d * 4 + g4] = (f32x4){o[d][4 * g4], o[d][4 * g4 + 1], o[d][4 * g4 + 2], o[d][4 * g4 + 3]}; }
                }
                float ss = 0.f;
#pragma unroll
                for (int d = 0; d < 4; ++d) {
#pragma unroll
                    for (int g4 = 0; g4 < 4; ++g4) { const f32x4 s0 = stash[d * 4 + g4];
#pragma unroll
                        for (int j = 0; j < 4; ++j) { const float v = s0[j] - lam * o[d][4 * g4 + j]; o[d][4 * g4 + j] = v; ss += v * v; } }
                    __builtin_amdgcn_sched_barrier(0); }
                ss += __shfl_xor(ss, 32);
                const float rinv = rsqrtf(ss * (1.0f / 128.0f) + RMS_EPS) * 0.8f;
                bf16_t* op = OA + row * 1024 + h * 128;
#pragma unroll
                for (int d = 0; d < 4; ++d)
#pragma unroll
                    for (int g4 = 0; g4 < 4; ++g4) { const int dd = 32 * d + 8 * g4 + 4 * hi; const f32x4 gs = *(const f32x4*)(a.in[10] + dd);
                        u32x2 w; w.x = cvt_pk_bf16(o[d][4 * g4 + 0] * rinv * gs[0], o[d][4 * g4 + 1] * rinv * gs[1]); w.y = cvt_pk_bf16(o[d][4 * g4 + 2] * rinv * gs[2], o[d][4 * g4 + 3] * rinv * gs[3]);
                        *(u32x2*)(op + dd) = w; }
            } } else if (TEST_ATT & 2) {
                const int qblk = ucode & 7, bh = useq & 31, b = bh >> 3, h = bh & 7, q0 = qblk * 256;
                const float sl2 = exp2f(-(float)(h + 1)) * LOG2E;
                const size_t row = (size_t)b * SEQ + q0 + wave * 32 + r32;
                const bf16_t* qp = PJ + row * PJ_LD + 2048 + h * 128;
                unsigned sel = 0u;
                if (qblk <= 3) sel = (1u << qblk) - 1u;
                else {
                    float qv[64];
#pragma unroll
                    for (int i = 0; i < 8; ++i) { const u32x4 w = *(const u32x4*)(qp + 64 * hi + 8 * i);
                        qv[8 * i + 0] = bf_lo(w.x); qv[8 * i + 1] = bf_hi(w.x); qv[8 * i + 2] = bf_lo(w.y); qv[8 * i + 3] = bf_hi(w.y); qv[8 * i + 4] = bf_lo(w.z); qv[8 * i + 5] = bf_hi(w.z); qv[8 * i + 6] = bf_lo(w.w); qv[8 * i + 7] = bf_hi(w.w); }
                    LAS float* kml = (LAS float*)(lds + 73728);
                    for (int idx = tid; idx < qblk * 128; idx += 512) { const float* kp = KMEAN + (size_t)(b * 8 + (idx >> 7)) * 2048 + h * 128 + (idx & 127); kml[idx] = kp[0] + kp[1024]; }
                    __syncthreads();
                    float gs[7];
#pragma unroll
                    for (int j = 0; j < 7; ++j) { gs[j] = 0.f;
                        if (j < qblk) { const LAS f32x4* km = (const LAS f32x4*)(kml + j * 128 + 64 * hi); float acc = 0.f;
#pragma unroll
                            for (int i = 0; i < 16; ++i) { const f32x4 k4 = km[i]; acc += qv[4 * i] * k4[0] + qv[4 * i + 1] * k4[1] + qv[4 * i + 2] * k4[2] + qv[4 * i + 3] * k4[3]; }
                            gs[j] = acc + __shfl_xor(acc, 32); }
                        __builtin_amdgcn_sched_barrier(0); }
#pragma unroll
                    for (int t = 0; t < 3; ++t) { float best = -INFINITY; int bi = 0;
#pragma unroll
                        for (int j = 0; j < 7; ++j) { if (j < qblk && !((sel >> j) & 1u) && gs[j] > best) { best = gs[j]; bi = j; } }
                        sel |= 1u << bi; }
                }
                f32x16 o[4];
                flash_pass<128, true>(lds, qp, PJ + (size_t)b * SEQ * PJ_LD + 3072 + h * 128, VT + (size_t)(1024 + h * 128) * VT_LD + (size_t)b * SEQ, q0, qblk, sl2, sel, o, tid);
                bf16_t* op = OB + row * 1024 + h * 128;
#pragma unroll
                for (int d = 0; d < 4; ++d)
#pragma unroll
                    for (int g4 = 0; g4 < 4; ++g4) { const int dd = 32 * d + 8 * g4 + 4 * hi;
                        u32x2 w; w.x = cvt_pk_bf16(o[d][4 * g4 + 0], o[d][4 * g4 + 1]); w.y = cvt_pk_bf16(o[d][4 * g4 + 2], o[d][4 * g4 + 3]);
                        *(u32x2*)(op + dd) = w; }
            }
        }
        if (G == 256) {
            PHASE_IDS();
            unsigned* cnt_f = (unsigned*)(a.ws + WS_BAR) + 7040;
            volatile LAS unsigned* wq2 = (volatile LAS unsigned*)(lds + LDS_BYTES - 128);
#pragma unroll 1
            for (;;) {
                __syncthreads();
                if (threadIdx.x == 0) wq2[0] = __hip_atomic_fetch_add(cnt_f, 1u, __ATOMIC_RELAXED, __HIP_MEMORY_SCOPE_AGENT);
                __syncthreads();
                const int it = WGU2_EARLY + __builtin_amdgcn_readfirstlane((int)wq2[0]) * 8 + wave;
                if (it - wave >= 5632) break;
                const ConvDesc A = conv_desc(a.in[15], 2048, 11264, 0, 11264, WGU, 0, a.in[14], 1, it);
                conv_pair(A, A, false, scr, lane);
            }
            __syncthreads();
        }
        if (ATT_DYNAMIC) {
            PHASE_IDS();
#pragma unroll 1
            for (;;) {
                unsigned itv = 0u; if (lane == 0) itv = __hip_atomic_fetch_add(cnt_c, 1u, __ATOMIC_RELAXED, __HIP_MEMORY_SCOPE_AGENT);
                const int it = __builtin_amdgcn_readfirstlane((int)itv);
                if (it >= 5632) break;
                const ConvDesc A = conv_desc(a.in[15], 2048, 11264, 0, 11264, WGU, 0, a.in[14], 1, it);
                conv_pair(A, A, false, scr, lane);
            }
        }
    }
    SEAM();
    if (PHASES & (1 << 6)) REP(6)
    {
    { Gemm g{OA, WPA, M_TOK, DMODEL, 1024}; StaticOrder S; S.init(M_TOK, DMODEL, G, (int)blockIdx.x); EpiGate<true> E{MG, PJ + 4096, PJ_LD};
      gemm_phase<EpiGate<true>, StaticOrder, true, true>(lds, g, S, E); }
    { Gemm g{OB, WPB, M_TOK, DMODEL, 1024}; StaticOrder S; S.init(M_TOK, DMODEL, G, (int)blockIdx.x); EpiGate<false> E{MG, PJ + 6144, PJ_LD};
      gemm_phase<EpiGate<false>, StaticOrder, true, true>(lds, g, S, E); }
    }
    SEAM();
    if (PHASES & (1 << 7)) REP(7)
    { Gemm g{MG, WO, M_TOK, DMODEL, DMODEL}; StaticOrder S; S.init(M_TOK, DMODEL, G, (int)blockIdx.x); EpiRes E{XR, XR, XB, SSQ2, 1.0f};
      gemm_phase<EpiRes, StaticOrder, true, true>(lds, g, S, E); }
    SEAM();
    if (PHASES & (1 << 8)) REP(8)
    {
    { Gemm g{XB, WGU, M_TOK, 2 * DFF, DMODEL}; StaticOrder S; S.init(M_TOK, 2 * DFF, G, (int)blockIdx.x); EpiSwiglu E{ACT, DFF, SSQ2};
      gemm_phase<EpiSwiglu, StaticOrder, true, true>(lds, g, S, E); }
    {
        PHASE_IDS();
        const int nwg = (M_TOK / 256) * (2 * DFF / 256), rounds = (nwg + G - 1) / G, rem = nwg - (rounds - 1) * G;
        int first = gw, stride = NGW;
        if (rem < G) { first = ((int)blockIdx.x - rem) * 8 + wave; stride = (G - rem) * 8; if ((int)blockIdx.x < rem) first = 1 << 30; }
        for (int it = first; it < 2816; it += stride) {
            const ConvDesc A = conv_desc(a.in[16], 5632, 2048, 0, 2048, WDN, 0, nullptr, 0, it);
            conv_pair(A, A, false, scr, lane);
        }
        __syncthreads();
    }
    }
    SEAM();
    if (G == 256) {
        Gemm g{ACT, WDN, M_TOK, DMODEL, DFF}; StaticOrder S; S.init(M_TOK, DMODEL, G, (int)blockIdx.x);
        EpiResNorm E{XR, XR, a.in[17], 0.5f, (float*)(ws + WS_XS), (unsigned*)(ws + WS_BAR) + 4096};
        gemm_phase<EpiResNorm, StaticOrder, false, true>(lds, g, S, E);
    } else {
    { Gemm g{ACT, WDN, M_TOK, DMODEL, DFF}; StaticOrder S; S.init(M_TOK, DMODEL, G, (int)blockIdx.x); EpiRes E{XR, XR, nullptr, SSQ3, 0.5f};
      gemm_phase<EpiRes, StaticOrder, true, true>(lds, g, S, E); }
    SEAM();
    {
        PHASE_IDS();
        const f32x4* gf = (const f32x4*)a.in[17] + lane;
        for (int row = gw; row < M_TOK; row += NGW) {
            const float rs = row_rstd(SSQ3, row);
            f32x4* xr = (f32x4*)(XR + (size_t)row * DMODEL) + lane;
            f32x4 xv[8];
#pragma unroll
            for (int j = 0; j < 8; ++j) xv[j] = xr[64 * j];
#pragma unroll
            for (int j = 0; j < 8; ++j) xr[64 * j] = xv[j] * rs * gf[64 * j];
        }
    }
    }
}

extern "C" void kernel_launch(void* const* d_in, const int* in_sizes, int n_in, void* d_out, int out_size, void* d_ws, size_t ws_size, hipStream_t stream) {
    static int grid_blocks = 0;
    if (grid_blocks == 0) {
        if (n_in != 18 || out_size != M_TOK * DMODEL || ws_size < WS_END) { fprintf(stderr, "kernel_launch: unexpected shapes (n_in %d out %d ws %zu)\n", n_in, out_size, ws_size); grid_blocks = -1; return; }
        int dev = 0, cus = 0, per_cu = 0;
        (void)hipGetDevice(&dev);
        (void)hipDeviceGetAttribute(&cus, hipDeviceAttributeMultiprocessorCount, dev);
        (void)hipFuncSetAttribute((const void*)mega_fwd, hipFuncAttributeMaxDynamicSharedMemorySize, LDS_BYTES);
        (void)hipOccupancyMaxActiveBlocksPerMultiprocessor(&per_cu, (const void*)mega_fwd, 512, LDS_BYTES);
        if (per_cu < 1) { fprintf(stderr, "kernel_launch: occupancy query says %d blocks per CU\n", per_cu); per_cu = 1; }
        grid_blocks = cus < 256 ? cus : 256;
        (void)hipGetLastError();
    }
    if (grid_blocks < 0) return;
    (void)hipMemsetAsync((unsigned char*)d_ws + WS_BAR, 0, BAR_BYTES, stream);
    Args a{};
    for (int i = 0; i < 18; ++i) a.in[i] = (const float*)d_in[i];
    a.out = (float*)d_out; a.ws = (unsigned char*)d_ws;
    void* args[] = {&a};
    hipError_t e = hipLaunchCooperativeKernel((const void*)mega_fwd, dim3(grid_blocks), dim3(512), args, LDS_BYTES, stream);
    if (e != hipSuccess) fprintf(stderr, "cooperative launch failed: %s (grid %d)\n", hipGetErrorString(e), grid_blocks);
}
```

```cpp
#include <hip/hip_runtime.h>
#include <hip/hip_cooperative_groups.h>
#include <cstdio>
#include <cstdint>
#include <cmath>
namespace cg = cooperative_groups;
namespace pg8 {
#define PG8_LAS __attribute__((address_space(3)))
typedef unsigned short bf16_t;
typedef short bf16x8 __attribute__((ext_vector_type(8)));
typedef float f32x4 __attribute__((ext_vector_type(4)));
typedef unsigned u32x4 __attribute__((ext_vector_type(4)));
constexpr int BM = 256, BK = 64, HALF = 128, HTB = HALF * BK * 2  , STAGE_BYTES = 8 * HTB, NXCD = 8, WGM = 8;

__host__ __device__ __forceinline__ int lds_byte(int r, int c) { const int st = (r >> 4) * 2 + (c >> 5), rr = r & 15, cc = c & 31, ob = rr * 64 + cc * 2; return st * 1024 + (ob ^ (((ob >> 9) & 1) << 5)); }
__host__ __device__ __forceinline__ void stage_rc(int b, int& R, int& C) { const int st = b / 1024, sb = b % 1024, swz = sb ^ (((sb >> 9) & 1) << 5); R = (st >> 1) * 16 + swz / 64; C = (st & 1) * 32 + (swz % 64) / 2; }
__host__ __device__ __forceinline__ int perm32(int rho) { const int n = rho >> 4, i = rho & 15; return 8 * (i >> 2) + 4 * n + (i & 3); }

struct Unit { int pm, pn; };
struct Gemm { const bf16_t* A; const bf16_t* Bt; int M, N, K; };

struct StaticOrder {
    int nM, nN, nwg, G, c;
    __host__ __device__ void init(int M, int N, int G_, int c_) { nM = M / BM; nN = N / BM; nwg = nM * nN; G = G_; c = c_; }
    __host__ __device__ bool next(int i, Unit& u) const {
        const long L = (long)i * G + c; if (L >= nwg) return false;
        int wgid = (int)L; { const int q = nwg / NXCD, r = nwg % NXCD, xcd = wgid % NXCD, off = wgid / NXCD; wgid = (xcd < r ? xcd * (q + 1) : r * (q + 1) + (xcd - r) * q) + off; }
        const int nig = WGM * nN, gid = wgid / nig, fm = gid * WGM, gsz = (nM - fm) < WGM ? (nM - fm) : WGM;
        u.pm = fm + ((wgid % nig) % gsz); u.pn = (wgid % nig) / gsz; return true;
    }
    __device__ __forceinline__ void a_ready(const Unit&) const {}
    __device__ __forceinline__ void done(const Unit&) const {}
};


typedef float f32x2 __attribute__((ext_vector_type(2)));
typedef unsigned u32x2 __attribute__((ext_vector_type(2)));
typedef __bf16 bf16x2_t __attribute__((ext_vector_type(2)));
__device__ __forceinline__ unsigned cvt_pk_bf16(float lo, float hi) { f32x2 v = {lo, hi}; bf16x2_t b = __builtin_convertvector(v, bf16x2_t); return __builtin_bit_cast(unsigned, b); }
__device__ __forceinline__ float bf_lo(unsigned u) { return __uint_as_float(u << 16); }
__device__ __forceinline__ float bf_hi(unsigned u) { return __uint_as_float(u & 0xffff0000u); }
constexpr int DMODEL = 2048;
constexpr float RMS_EPS = 1e-6f;
constexpr float LOG2E = 1.4426950408889634f;
__device__ __forceinline__ float row_rstd(const float* ssq, int row) {
    const f32x4* p = (const f32x4*)(ssq + (size_t)row * 32);
    float s = 0.f;
#pragma unroll
    for (int i = 0; i < 8; ++i) { const f32x4 v = p[i]; s += (v[0] + v[1]) + (v[2] + v[3]); }
    return __builtin_amdgcn_rsqf(s * (1.0f / DMODEL) + RMS_EPS);
}
__device__ __forceinline__ void rows_rstd(const float* ssq, int row0, int fq, float scale, float (&rs)[2][4]) {
    f32x4 pa[2][4], pb[2][4];
#pragma unroll
    for (int ai = 0; ai < 2; ++ai)
#pragma unroll
        for (int m = 0; m < 4; ++m) { const f32x4* p = (const f32x4*)(ssq + (size_t)(row0 + ai * HALF + m * 16) * 32 + 8 * fq); pa[ai][m] = p[0]; pb[ai][m] = p[1]; }
#pragma unroll
    for (int ai = 0; ai < 2; ++ai)
#pragma unroll
        for (int m = 0; m < 4; ++m) { const f32x4 a = pa[ai][m], c = pb[ai][m]; float s = ((a[0] + a[1]) + (a[2] + a[3])) + ((c[0] + c[1]) + (c[2] + c[3]));
            s += __shfl_xor(s, 16); s += __shfl_xor(s, 32); rs[ai][m] = __builtin_amdgcn_rsqf(s * (1.0f / DMODEL) + RMS_EPS) * scale; }
}
__device__ __forceinline__ float silu_f(float x) { return x * __builtin_amdgcn_rcpf(1.0f + __builtin_amdgcn_exp2f(-x * LOG2E)); }
__device__ __forceinline__ float sigmoid_f(float x) { return __builtin_amdgcn_rcpf(1.0f + __builtin_amdgcn_exp2f(-x * LOG2E)); }

struct EpiSwiglu {
    static constexpr bool PERM = true, AFTER_DRAIN = false;
    bf16_t* O; int ldo; const float* ssq;
    __device__ __forceinline__ void operator()(const f32x4 (&acc)[2][2][4][2], const Unit& u, int wr, int wc, int fr, int fq) const {
        const int row0 = u.pm * BM + wr * 64 + fr, col0 = u.pn * HALF + wc * 32 + 8 * fq;
        float rs[2][4];
        rows_rstd(ssq, row0, fq, 1.0f, rs);
#pragma unroll
        for (int ai = 0; ai < 2; ++ai)
#pragma unroll
            for (int m = 0; m < 4; ++m) { const int row = row0 + ai * HALF + m * 16; const float r = rs[ai][m];
                const f32x4 g0 = acc[ai][0][m][0] * r, g1 = acc[ai][0][m][1] * r, u0 = acc[ai][1][m][0] * r, u1 = acc[ai][1][m][1] * r;
                u32x4 w;
                w.x = cvt_pk_bf16(silu_f(g0[0]) * u0[0], silu_f(g0[1]) * u0[1]); w.y = cvt_pk_bf16(silu_f(g0[2]) * u0[2], silu_f(g0[3]) * u0[3]);
                w.z = cvt_pk_bf16(silu_f(g1[0]) * u1[0], silu_f(g1[1]) * u1[1]); w.w = cvt_pk_bf16(silu_f(g1[2]) * u1[2], silu_f(g1[3]) * u1[3]);
                *(u32x4*)(O + (size_t)row * ldo + col0) = w; }
    }
};
struct EpiRes {
    static constexpr bool PERM = false, AFTER_DRAIN = false;
    const float* base; float* out; bf16_t* outb; float* ssq_out; float alpha;
    __device__ __forceinline__ void operator()(const f32x4 (&acc)[2][2][4][2], const Unit& u, int wr, int wc, int fr, int fq) const {
        const int row0 = u.pm * BM + wr * 64 + fr, col0 = u.pn * BM + wc * 32 + 4 * fq;
#pragma unroll
        for (int ai = 0; ai < 2; ++ai) {
            f32x4 bs[4][2][2];
#pragma unroll
            for (int m = 0; m < 4; ++m)
#pragma unroll
                for (int bj = 0; bj < 2; ++bj)
#pragma unroll
                    for (int n = 0; n < 2; ++n) bs[m][bj][n] = *(const f32x4*)(base + (size_t)(row0 + ai * HALF + m * 16) * DMODEL + col0 + bj * HALF + n * 16);
#pragma unroll
            for (int m = 0; m < 4; ++m) { const int row = row0 + ai * HALF + m * 16; const size_t off = (size_t)row * DMODEL + col0; float sq = 0.f;
#pragma unroll
                for (int bj = 0; bj < 2; ++bj)
#pragma unroll
                    for (int n = 0; n < 2; ++n) { const size_t o2 = off + bj * HALF + n * 16; const f32x4 o = bs[m][bj][n] + acc[ai][bj][m][n] * alpha;
                        *(f32x4*)(out + o2) = o; sq += (o[0] * o[0] + o[1] * o[1]) + (o[2] * o[2] + o[3] * o[3]);
                        if (outb) { u32x2 w; w.x = cvt_pk_bf16(o[0], o[1]); w.y = cvt_pk_bf16(o[2], o[3]); *(u32x2*)(outb + o2) = w; } }
                sq += __shfl_xor(sq, 16); sq += __shfl_xor(sq, 32);
                if (fq == 0) ssq_out[(size_t)row * 32 + u.pn * 4 + wc] = sq; }
        }
    }
};
struct EpiProj {
    static constexpr bool PERM = true, AFTER_DRAIN = false;
    bf16_t* O; int ldo; const float* ssq; float qa_scale, qb_scale; float* kpart;
    __device__ __forceinline__ void operator()(const f32x4 (&acc)[2][2][4][2], const Unit& u, int wr, int wc, int fr, int fq) const {
        const int row0 = u.pm * BM + wr * 64 + fr, col0 = u.pn * BM + wc * 32 + 8 * fq;
        const bool sig = u.pn >= 16; const float sc = u.pn < 4 ? qa_scale : ((u.pn >= 8 && u.pn < 12) ? qb_scale : 1.0f);
        float rs[2][4];
        rows_rstd(ssq, row0, fq, sc, rs);
#pragma unroll
        for (int ai = 0; ai < 2; ++ai)
#pragma unroll
            for (int m = 0; m < 4; ++m) { const int row = row0 + ai * HALF + m * 16; const float r = rs[ai][m];
#pragma unroll
                for (int bj = 0; bj < 2; ++bj) { f32x4 v0 = acc[ai][bj][m][0] * r, v1 = acc[ai][bj][m][1] * r;
                    if (sig) {
#pragma unroll
                        for (int j = 0; j < 4; ++j) { v0[j] = sigmoid_f(v0[j]); v1[j] = sigmoid_f(v1[j]); } }
                    u32x4 w; w.x = cvt_pk_bf16(v0[0], v0[1]); w.y = cvt_pk_bf16(v0[2], v0[3]); w.z = cvt_pk_bf16(v1[0], v1[1]); w.w = cvt_pk_bf16(v1[2], v1[3]);
                    *(u32x4*)(O + (size_t)row * ldo + col0 + bj * HALF) = w; } }
        if (u.pn >= 12 && u.pn < 16) {
#pragma unroll
            for (int bj = 0; bj < 2; ++bj) { f32x4 s0 = {0.f, 0.f, 0.f, 0.f}, s1 = {0.f, 0.f, 0.f, 0.f};
#pragma unroll
                for (int ai = 0; ai < 2; ++ai)
#pragma unroll
                    for (int m = 0; m < 4; ++m) { s0 += acc[ai][bj][m][0] * rs[ai][m]; s1 += acc[ai][bj][m][1] * rs[ai][m]; }
#pragma unroll
                for (int j = 0; j < 4; ++j) {
#pragma unroll
                    for (int o = 1; o < 16; o <<= 1) { s0[j] += __shfl_xor(s0[j], o); s1[j] += __shfl_xor(s1[j], o); } }
                if (fr == 0) { float* kp = kpart + ((size_t)u.pm * 2 + wr) * 1024 + (col0 - 3072) + bj * HALF; *(f32x4*)kp = s0; *(f32x4*)(kp + 4) = s1; } }
        }
    }
};
struct EpiVt {
    static constexpr bool PERM = true, AFTER_DRAIN = false;
    bf16_t* O; int ldo; const float* ssq;
    __device__ __forceinline__ void operator()(const f32x4 (&acc)[2][2][4][2], const Unit& u, int wr, int wc, int fr, int fq) const {
        const int row0 = u.pm * BM + wr * 64 + fr, col0 = u.pn * BM + wc * 32 + 8 * fq;
        f32x4 rs[2][2];
        {
            const float mine = row_rstd(ssq, u.pn * BM + (fr >> 3) * HALF + wc * 32 + 8 * fq + (fr & 7));
            const int lbase = fq * 16;
#pragma unroll
            for (int bj = 0; bj < 2; ++bj)
#pragma unroll
                for (int n = 0; n < 2; ++n)
#pragma unroll
                    for (int j = 0; j < 4; ++j) rs[bj][n][j] = __shfl(mine, lbase + bj * 8 + n * 4 + j);
        }
#pragma unroll
        for (int ai = 0; ai < 2; ++ai)
#pragma unroll
            for (int m = 0; m < 4; ++m) { const int row = row0 + ai * HALF + m * 16;
#pragma unroll
                for (int bj = 0; bj < 2; ++bj) { const f32x4 v0 = acc[ai][bj][m][0] * rs[bj][0], v1 = acc[ai][bj][m][1] * rs[bj][1];
                    u32x4 w; w.x = cvt_pk_bf16(v0[0], v0[1]); w.y = cvt_pk_bf16(v0[2], v0[3]); w.z = cvt_pk_bf16(v1[0], v1[1]); w.w = cvt_pk_bf16(v1[2], v1[3]);
                    *(u32x4*)(O + (size_t)row * ldo + col0 + bj * HALF) = w; } }
    }
};
template <bool FIRST> struct EpiGate {
    static constexpr bool PERM = true, AFTER_DRAIN = false;
    bf16_t* T; const bf16_t* sig; int ldsig;
    __device__ __forceinline__ void operator()(const f32x4 (&acc)[2][2][4][2], const Unit& u, int wr, int wc, int fr, int fq) const {
        const int row0 = u.pm * BM + wr * 64 + fr, col0 = u.pn * BM + wc * 32 + 8 * fq;
#pragma unroll
        for (int ai = 0; ai < 2; ++ai) {
            u32x4 sg[4][2], tt[4][2];
#pragma unroll
            for (int m = 0; m < 4; ++m)
#pragma unroll
                for (int bj = 0; bj < 2; ++bj) { const int row = row0 + ai * HALF + m * 16, col = col0 + bj * HALF;
                    sg[m][bj] = *(const u32x4*)(sig + (size_t)row * ldsig + col);
                    if (!FIRST) tt[m][bj] = *(const u32x4*)(T + (size_t)row * DMODEL + col); }
#pragma unroll
            for (int m = 0; m < 4; ++m) { const int row = row0 + ai * HALF + m * 16;
#pragma unroll
                for (int bj = 0; bj < 2; ++bj) { const int col = col0 + bj * HALF;
                    const u32x4 s = sg[m][bj];
                    const f32x4 a0 = acc[ai][bj][m][0], a1 = acc[ai][bj][m][1];
                    float v[8];
                    v[0] = bf_lo(s.x) * a0[0]; v[1] = bf_hi(s.x) * a0[1]; v[2] = bf_lo(s.y) * a0[2]; v[3] = bf_hi(s.y) * a0[3];
                    v[4] = bf_lo(s.z) * a1[0]; v[5] = bf_hi(s.z) * a1[1]; v[6] = bf_lo(s.w) * a1[2]; v[7] = bf_hi(s.w) * a1[3];
                    bf16_t* tp = T + (size_t)row * DMODEL + col;
                    if (!FIRST) { const u32x4 t = tt[m][bj];
                        v[0] += bf_lo(t.x); v[1] += bf_hi(t.x); v[2] += bf_lo(t.y); v[3] += bf_hi(t.y); v[4] += bf_lo(t.z); v[5] += bf_hi(t.z); v[6] += bf_lo(t.w); v[7] += bf_hi(t.w); }
                    u32x4 w; w.x = cvt_pk_bf16(v[0], v[1]); w.y = cvt_pk_bf16(v[2], v[3]); w.z = cvt_pk_bf16(v[4], v[5]); w.w = cvt_pk_bf16(v[6], v[7]);
                    *(u32x4*)tp = w; } }
        }
    }
};

struct EpiResNorm {
    static constexpr bool PERM = false, AFTER_DRAIN = true;
    const float* base; float* out; const float* gain; float alpha; float* xs; unsigned* cnt;
    __device__ __forceinline__ void operator()(const f32x4 (&)[2][2][4][2], const Unit&, int, int, int, int) const {}
    __device__ __forceinline__ void fused(f32x4 (&acc)[2][2][4][2], const Unit& u, int wr, int wc, int fr, int fq, PG8_LAS unsigned char* lds, int wid, int lane) const {
        PG8_LAS float* P = (PG8_LAS float*)lds;
        PG8_LAS float* S = (PG8_LAS float*)(lds + 8192);
        const int row0 = u.pm * BM + wr * 64 + fr, col0 = u.pn * BM + wc * 32 + 4 * fq;
#pragma unroll
        for (int ai = 0; ai < 2; ++ai) {
            f32x4 bs[4][2][2];
#pragma unroll
            for (int m = 0; m < 4; ++m)
#pragma unroll
                for (int bj = 0; bj < 2; ++bj)
#pragma unroll
                    for (int n = 0; n < 2; ++n) bs[m][bj][n] = *(const f32x4*)(base + (size_t)(row0 + ai * HALF + m * 16) * DMODEL + col0 + bj * HALF + n * 16);
#pragma unroll
            for (int m = 0; m < 4; ++m) { float sq = 0.f;
#pragma unroll
                for (int bj = 0; bj < 2; ++bj)
#pragma unroll
                    for (int n = 0; n < 2; ++n) { const f32x4 o = bs[m][bj][n] + acc[ai][bj][m][n] * alpha; acc[ai][bj][m][n] = o; sq += (o[0] * o[0] + o[1] * o[1]) + (o[2] * o[2] + o[3] * o[3]); }
                sq += __shfl_xor(sq, 16); sq += __shfl_xor(sq, 32);
                if (fq == 0) P[(ai * HALF + wr * 64 + m * 16 + fr) * 4 + wc] = sq; }
        }
        asm volatile("s_waitcnt lgkmcnt(0)" ::: "memory"); __builtin_amdgcn_s_barrier(); asm volatile("" ::: "memory");
        const int row = wid * 32 + (lane & 31);
        if (lane < 32) { const float t = (P[row * 4 + 0] + P[row * 4 + 1]) + (P[row * 4 + 2] + P[row * 4 + 3]);
            __hip_atomic_store(xs + (size_t)(u.pm * BM + row) * 8 + u.pn, t, __ATOMIC_RELAXED, __HIP_MEMORY_SCOPE_AGENT); }
        asm volatile("s_waitcnt vmcnt(0)" ::: "memory");
        if (lane == 0) __hip_atomic_fetch_add(cnt + 64 * u.pm, 1u, __ATOMIC_RELAXED, __HIP_MEMORY_SCOPE_AGENT);
        if (wid == 0) {
            for (unsigned sp = 0; sp < (1u << 22); ++sp) {
                if ((unsigned)__builtin_amdgcn_readfirstlane(__hip_atomic_load(cnt + 64 * u.pm, __ATOMIC_RELAXED, __HIP_MEMORY_SCOPE_AGENT)) >= 64u) break;
                __builtin_amdgcn_s_sleep(2);
            }
            __builtin_amdgcn_fence(__ATOMIC_ACQUIRE, "agent");
        }
        asm volatile("s_waitcnt vmcnt(0) lgkmcnt(0)" ::: "memory"); __builtin_amdgcn_s_barrier(); asm volatile("" ::: "memory");
        if (lane < 32) { const float* sl = xs + (size_t)(u.pm * BM + row) * 8; float t[8];
#pragma unroll
            for (int i = 0; i < 8; ++i) t[i] = __hip_atomic_load(sl + i, __ATOMIC_RELAXED, __HIP_MEMORY_SCOPE_AGENT);
            const float tot = ((t[0] + t[1]) + (t[2] + t[3])) + ((t[4] + t[5]) + (t[6] + t[7]));
            S[row] = __builtin_amdgcn_rsqf(tot * (1.0f / DMODEL) + RMS_EPS); }
        asm volatile("s_waitcnt lgkmcnt(0)" ::: "memory"); __builtin_amdgcn_s_barrier(); asm volatile("" ::: "memory");
        f32x4 gv[2][2];
#pragma unroll
        for (int bj = 0; bj < 2; ++bj)
#pragma unroll
            for (int n = 0; n < 2; ++n) gv[bj][n] = *(const f32x4*)(gain + col0 + bj * HALF + n * 16);
#pragma unroll
        for (int ai = 0; ai < 2; ++ai)
#pragma unroll
            for (int m = 0; m < 4; ++m) { const int rl = ai * HALF + wr * 64 + m * 16 + fr; const float rs = S[rl]; const size_t off = (size_t)(u.pm * BM + rl) * DMODEL + col0;
#pragma unroll
                for (int bj = 0; bj < 2; ++bj)
#pragma unroll
                    for (int n = 0; n < 2; ++n) *(f32x4*)(out + off + bj * HALF + n * 16) = acc[ai][bj][m][n] * rs * gv[bj][n]; }
    }
};

template <class Epi, class Sched, bool ALIGN_EPI = false, bool SP2 = false>
__device__ __forceinline__ void gemm_phase(PG8_LAS unsigned char* lds, const Gemm g, const Sched& S, const Epi& E) {
    int tid_o = threadIdx.x; asm volatile("" : "+v"(tid_o));
    const int tid = tid_o, wid = __builtin_amdgcn_readfirstlane(tid >> 6), lane = tid & 63, wr = wid >> 2, wc = wid & 3, fr = lane & 15, fq = lane >> 4;
    const int K = g.K, nt = K / BK;
    unsigned voffA[2], voffB[2];
#pragma unroll
    for (int i = 0; i < 2; ++i) { int R, C; stage_rc(tid * 16 + i * 8192, R, C); const int Rb = Epi::PERM ? ((R & ~31) + perm32(R & 31)) : R;
        voffA[i] = (unsigned)(R * K + C) * 2u; voffB[i] = (unsigned)(Rb * K + C) * 2u; }
    const size_t kstep = (size_t)(BK * 2);
    const size_t hstep = (size_t)HALF * K * 2;
    const size_t tstep = 2 * hstep;
    const unsigned ldsw = (unsigned)wid * 1024u;
    const int aoff = lds_byte(wr * 64 + fr, fq * 8), boff = lds_byte(wc * 32 + fr, fq * 8);
#define PG8_SA(b, h) (((b) * 2 + (h)) * HTB)
#define PG8_SB(b, h) ((4 + (b) * 2 + (h)) * HTB)
#define PG8_STAGE(bufoff, gbase, voff) do { _Pragma("unroll") for (int _i = 0; _i < 2; ++_i) \
        __builtin_amdgcn_global_load_lds((const unsigned*)((const char*)(gbase) + (voff)[_i]), (PG8_LAS unsigned*)(lds + (bufoff) + ldsw + _i * 8192), 16, 0, 0); } while (0)
#define PG8_LDA(dst, b, h) do { _Pragma("unroll") for (int m = 0; m < 4; ++m) _Pragma("unroll") for (int k = 0; k < 2; ++k) dst[m][k] = *(const PG8_LAS bf16x8*)(lds + PG8_SA(b, h) + aoff + m * 2048 + k * 1024); } while (0)
#define PG8_LDB(dst, b, h) do { _Pragma("unroll") for (int n = 0; n < 2; ++n) _Pragma("unroll") for (int k = 0; k < 2; ++k) dst[n][k] = *(const PG8_LAS bf16x8*)(lds + PG8_SB(b, h) + boff + n * 2048 + k * 1024); } while (0)
#define PG8_MMA(ai, bj, At, Bt) do { __builtin_amdgcn_s_setprio(1); _Pragma("unroll") for (int m = 0; m < 4; ++m) _Pragma("unroll") for (int n = 0; n < 2; ++n) _Pragma("unroll") for (int k = 0; k < 2; ++k) \
        acc[ai][bj][m][n] = __builtin_amdgcn_mfma_f32_16x16x32_bf16(Bt[n][k], At[m][k], acc[ai][bj][m][n], 0, 0, 0); __builtin_amdgcn_s_setprio(0); } while (0)
#define PG8_WAIT_V(n) asm volatile("s_waitcnt vmcnt(" #n ")" ::: "memory")
#define PG8_WAIT_L(n) asm volatile("s_waitcnt lgkmcnt(" #n ")" ::: "memory")
#define PG8_BAR __builtin_amdgcn_s_barrier()
#define PG8_SCHED __builtin_amdgcn_sched_barrier(0)
    Unit cur, nxt; int ui = 0;
    if (!S.next(0, cur)) return;
    f32x4 acc[2][2][4][2];
#pragma unroll
    for (int a = 0; a < 2; ++a)
#pragma unroll
        for (int b = 0; b < 2; ++b)
#pragma unroll
            for (int m = 0; m < 4; ++m)
#pragma unroll
                for (int n = 0; n < 2; ++n) acc[a][b][m][n] = (f32x4){0.f, 0.f, 0.f, 0.f};
    bf16x8 At[4][2], B0[2][2], B1[2][2];
    const char* cA = (const char*)g.A + (size_t)cur.pm * tstep; const char* cB = (const char*)g.Bt + (size_t)cur.pn * tstep;
    S.a_ready(cur);
    if constexpr (SP2) {
        PG8_STAGE(PG8_SB(0, 0), cB, voffB); PG8_STAGE(PG8_SB(0, 1), cB + hstep, voffB); PG8_STAGE(PG8_SA(0, 0), cA, voffA); PG8_STAGE(PG8_SA(0, 1), cA + hstep, voffA);
        if (wr == 1) PG8_BAR;
        PG8_WAIT_V(2); PG8_BAR;
        PG8_STAGE(PG8_SB(1, 0), cB + kstep, voffB); PG8_STAGE(PG8_SA(1, 0), cA + kstep, voffA); PG8_STAGE(PG8_SB(1, 1), cB + hstep + kstep, voffB);
        PG8_WAIT_V(6); PG8_BAR;
    } else {
        PG8_STAGE(PG8_SB(0, 0), cB, voffB); PG8_STAGE(PG8_SA(0, 0), cA, voffA); PG8_STAGE(PG8_SB(0, 1), cB + hstep, voffB); PG8_STAGE(PG8_SA(0, 1), cA + hstep, voffA);
        if (wr == 1) PG8_BAR;
        PG8_WAIT_V(4); PG8_BAR;
        PG8_STAGE(PG8_SB(1, 0), cB + kstep, voffB); PG8_STAGE(PG8_SA(1, 0), cA + kstep, voffA); PG8_STAGE(PG8_SB(1, 1), cB + hstep + kstep, voffB);
        PG8_WAIT_V(6); PG8_BAR;
    }
    for (;;) {
        const bool has_next = S.next(ui + 1, nxt);
        const char* nA = has_next ? (const char*)g.A + (size_t)nxt.pm * tstep : cA; const char* nB = has_next ? (const char*)g.Bt + (size_t)nxt.pn * tstep : cB;
        for (int t = 0; t < nt; t += 2) {
            const bool last = (t == nt - 2);
            const char* a1 = cA + (size_t)(t + 1) * kstep;
            const char* a2 = last ? nA : cA + (size_t)(t + 2) * kstep; const char* b2 = last ? nB : cB + (size_t)(t + 2) * kstep;
            const char* a3 = a2 + kstep; const char* b3 = b2 + kstep;
            if (last && has_next) S.a_ready(nxt);
            if constexpr (SP2) {
            PG8_LDB(B0, 0, 0); PG8_LDB(B1, 0, 1); PG8_SCHED; PG8_LDA(At, 0, 0); PG8_STAGE(PG8_SA(1, 1), a1 + hstep, voffA);
            PG8_WAIT_V(8); PG8_WAIT_L(0); PG8_BAR; PG8_MMA(0, 0, At, B0); PG8_MMA(0, 1, At, B1); PG8_BAR; PG8_SCHED;
            PG8_LDA(At, 0, 1); PG8_STAGE(PG8_SB(0, 0), b2, voffB); PG8_STAGE(PG8_SB(0, 1), b2 + hstep, voffB); PG8_STAGE(PG8_SA(0, 0), a2, voffA);
            PG8_WAIT_V(8); PG8_WAIT_L(0); PG8_BAR; PG8_MMA(1, 0, At, B0); PG8_MMA(1, 1, At, B1); PG8_BAR; PG8_SCHED;
            PG8_LDB(B0, 1, 0); PG8_LDB(B1, 1, 1); PG8_SCHED; PG8_LDA(At, 1, 0); PG8_STAGE(PG8_SA(0, 1), a2 + hstep, voffA);
            PG8_WAIT_V(8); PG8_WAIT_L(0); PG8_BAR; PG8_MMA(0, 0, At, B0); PG8_MMA(0, 1, At, B1); PG8_BAR; PG8_SCHED;
            PG8_LDA(At, 1, 1); PG8_STAGE(PG8_SB(1, 0), b3, voffB); PG8_STAGE(PG8_SB(1, 1), b3 + hstep, voffB); PG8_STAGE(PG8_SA(1, 0), a3, voffA);
            PG8_WAIT_V(8); PG8_WAIT_L(0); PG8_BAR; PG8_MMA(1, 0, At, B0); PG8_MMA(1, 1, At, B1); PG8_BAR; PG8_SCHED;
            } else {
            PG8_LDB(B0, 0, 0); PG8_SCHED; PG8_LDA(At, 0, 0); PG8_STAGE(PG8_SA(1, 1), a1 + hstep, voffA);
            PG8_WAIT_L(8); PG8_BAR; PG8_WAIT_L(0); PG8_MMA(0, 0, At, B0); PG8_BAR; PG8_SCHED;
            PG8_LDB(B1, 0, 1); PG8_STAGE(PG8_SB(0, 0), b2, voffB);
            PG8_BAR; PG8_WAIT_L(0); PG8_MMA(0, 1, At, B1); PG8_BAR;
            PG8_LDA(At, 0, 1); PG8_STAGE(PG8_SA(0, 0), a2, voffA);
            PG8_BAR; PG8_WAIT_L(0); PG8_MMA(1, 0, At, B0); PG8_BAR; PG8_SCHED;
            PG8_STAGE(PG8_SB(0, 1), b2 + hstep, voffB);
            PG8_WAIT_V(6); PG8_BAR; PG8_MMA(1, 1, At, B1); PG8_BAR;
            PG8_LDB(B0, 1, 0); PG8_SCHED; PG8_LDA(At, 1, 0); PG8_STAGE(PG8_SA(0, 1), a2 + hstep, voffA);
            PG8_WAIT_L(8); PG8_BAR; PG8_WAIT_L(0); PG8_MMA(0, 0, At, B0); PG8_BAR; PG8_SCHED;
            PG8_LDB(B1, 1, 1); PG8_STAGE(PG8_SB(1, 0), b3, voffB);
            PG8_BAR; PG8_WAIT_L(0); PG8_MMA(0, 1, At, B1); PG8_BAR;
            PG8_LDA(At, 1, 1); PG8_STAGE(PG8_SA(1, 0), a3, voffA);
            PG8_BAR; PG8_WAIT_L(0); PG8_MMA(1, 0, At, B0); PG8_BAR; PG8_SCHED;
            PG8_STAGE(PG8_SB(1, 1), b3 + hstep, voffB);
            PG8_WAIT_V(6); PG8_BAR; PG8_MMA(1, 1, At, B1); PG8_BAR;
            }
        }
        if constexpr (ALIGN_EPI) { if (wr == 0) PG8_BAR; }
        if constexpr (!Epi::AFTER_DRAIN) { E(acc, cur, wr, wc, fr, fq); S.done(cur); }
        if (!has_next) break;
#pragma unroll
        for (int a = 0; a < 2; ++a)
#pragma unroll
            for (int b = 0; b < 2; ++b)
#pragma unroll
                for (int m = 0; m < 4; ++m)
#pragma unroll
                    for (int n = 0; n < 2; ++n) acc[a][b][m][n] = (f32x4){0.f, 0.f, 0.f, 0.f};
        cur = nxt; cA = nA; cB = nB; ++ui;
        if constexpr (ALIGN_EPI) { if (wr == 1) PG8_BAR; }
    }
    PG8_WAIT_V(0);
    if constexpr (!ALIGN_EPI) { if (wr == 0) PG8_BAR; }
    PG8_BAR;
    if constexpr (Epi::AFTER_DRAIN) { E.fused(acc, cur, wr, wc, fr, fq, lds, wid, lane); S.done(cur); }
#undef PG8_SA
#undef PG8_SB
#undef PG8_STAGE
#undef PG8_LDA
#undef PG8_LDB
#undef PG8_MMA
#undef PG8_WAIT_V
#undef PG8_WAIT_L
#undef PG8_BAR
#undef PG8_SCHED
}
}

using namespace pg8;
#define LAS __attribute__((address_space(3)))
typedef float f32x16 __attribute__((ext_vector_type(16)));

constexpr int BATCH = 4, SEQ = 2048, M_TOK = BATCH * SEQ, DFF = 5632;
constexpr int PJ_LD = 8192;
constexpr int VT_LD = M_TOK;
constexpr float QA_SCALE = 0.125f * LOG2E, QB_SCALE = 0.08838834764831845f * LOG2E;

constexpr size_t MiB = 1u << 20;
constexpr size_t WS_SSQ0 = 0, WS_SSQ1 = 1 * MiB, WS_SSQ2 = 2 * MiB, WS_SSQ3 = 3 * MiB, WS_KMEAN = 4 * MiB, WS_XS = 4 * MiB + 512 * 1024, WS_BAR = 5 * MiB, BAR_BYTES = 32768;
constexpr size_t WS_WGU = 8 * MiB, WS_WDN = 52 * MiB, WS_WIN = 74 * MiB, WS_WV = 106 * MiB, WS_WPA = 114 * MiB, WS_WPB = 118 * MiB, WS_WO = 122 * MiB;
constexpr size_t WS_XB = 130 * MiB, WS_ACT = 162 * MiB, WS_OA = WS_ACT, WS_OB = WS_ACT + 16 * MiB, WS_PJ = 250 * MiB, WS_VT = 378 * MiB, WS_END = 410 * MiB;
constexpr size_t WS_WGU1 = WS_PJ, WS_WDN1 = WS_PJ + 44 * MiB;

constexpr int TAIL1_EXTRA = 7168;
constexpr int WGU2_EARLY = 3328;
constexpr int LDS_BYTES = 147456;

__device__ __forceinline__ float wave_sum(float v) {
#pragma unroll
    for (int o = 1; o < 64; o <<= 1) v += __shfl_xor(v, o);
    return v;
}
struct ConvDesc { const float* src; bf16_t* dst; const float* g; int Nsrc, K; };
#ifndef CONV_MODE
#define CONV_MODE 1
#endif
__device__ __forceinline__ ConvDesc conv_desc(const float* W, int K, int Nsrc, int c0, int nc, bf16_t* WT, int r0, const float* g, int mode, int item) {
    const int nblk = nc / 64;
    int kb, nb;
    if (CONV_MODE == 0) { kb = item / nblk; nb = item % nblk; }
    else { const int j = item & 7, t = item >> 3; nb = t % nblk; kb = (t / nblk) * 8 + j; }
    const int loc = 64 * nb;
    int dst = r0 + loc;
    if (mode == 1) { const int half = nc / 2; const int l2 = loc < half ? loc : loc - half; dst = r0 + 256 * (l2 / 128) + (l2 % 128) + (loc < half ? 0 : 128); }
    ConvDesc d; d.src = W + (size_t)(64 * kb) * Nsrc + c0 + loc; d.dst = WT + (size_t)dst * K + 64 * kb; d.g = g ? g + 64 * kb : nullptr; d.Nsrc = Nsrc; d.K = K;
    return d;
}
__device__ __forceinline__ void conv_load(const ConvDesc& d, f32x4 (&v)[16], int lane) {
    const int kq = lane >> 4, n4 = (lane & 15) * 4;
    const float* src = d.src + (size_t)(2 * kq) * d.Nsrc + n4;
#pragma unroll
    for (int i = 0; i < 8; ++i) { v[2 * i] = __builtin_nontemporal_load((const f32x4*)(src + (size_t)(8 * i) * d.Nsrc)); v[2 * i + 1] = __builtin_nontemporal_load((const f32x4*)(src + (size_t)(8 * i + 1) * d.Nsrc)); }
}
__device__ __forceinline__ void conv_scatter(const ConvDesc& d, f32x4 (&v)[16], LAS unsigned* scr, int lane) {
    const int kq = lane >> 4, n4 = (lane & 15) * 4;
    if (d.g) {
#pragma unroll
        for (int i = 0; i < 8; ++i) { const f32x2 gg = *(const f32x2*)(d.g + 8 * i + 2 * kq); v[2 * i] = v[2 * i] * gg.x; v[2 * i + 1] = v[2 * i + 1] * gg.y; } }
#pragma unroll
    for (int i = 0; i < 8; ++i)
#pragma unroll
        for (int j = 0; j < 4; ++j) scr[(n4 + j) * 33 + 4 * i + kq] = cvt_pk_bf16(v[2 * i][j], v[2 * i + 1][j]);
}
__device__ __forceinline__ void conv_store(const ConvDesc& d, const LAS unsigned* scr, int lane) {
    const int c = lane & 7, nl = lane >> 3;
#pragma unroll
    for (int jj = 0; jj < 8; ++jj) { const int n = nl + 8 * jj; const LAS unsigned* sp = scr + n * 33 + 4 * c;
        u32x4 o; o.x = sp[0]; o.y = sp[1]; o.z = sp[2]; o.w = sp[3];
        *(u32x4*)(d.dst + (size_t)n * d.K + 8 * c) = o; }
}
__device__ __forceinline__ void conv_pair(const ConvDesc& A, const ConvDesc& B, bool hasB, LAS unsigned* scr, int lane) {
    f32x4 va[16], vb[16];
    conv_load(A, va, lane);
    if (hasB) conv_load(B, vb, lane);
    conv_scatter(A, va, scr, lane);
    if (hasB) conv_scatter(B, vb, scr + 2112, lane);
    asm volatile("s_waitcnt lgkmcnt(0)" ::: "memory");
    conv_store(A, scr, lane);
    if (hasB) conv_store(B, scr + 2112, lane);
    asm volatile("s_waitcnt lgkmcnt(0)" ::: "memory");
}

constexpr int ATT_KPMAX = 272, ATT_VP = 144;
constexpr int ATT_LDS_KB = 64 * ATT_KPMAX, ATT_LDS_V0 = 2 * ATT_LDS_KB, ATT_LDS_VB = 128 * ATT_VP;
constexpr float ATT_NEG = -1e30f;
#define MFMA32(a, b, c) __builtin_amdgcn_mfma_f32_32x32x16_bf16((a), (b), (c), 0, 0, 0)

template <int DH, bool MOBA>
__device__ __forceinline__ void flash_pass(LAS unsigned char* lds, const bf16_t* qrow, const bf16_t* kbase, const bf16_t* vtbase, int q0, int qblk, float sl2, unsigned sel, f32x16 (&o)[4], int tid) {
    const int lane = tid & 63, r32 = lane & 31, hi = lane >> 5, wid = __builtin_amdgcn_readfirstlane(tid >> 6);
    constexpr int KP = DH * 2 + 16, KPIECES = DH / 8, KLD = (64 * KPIECES) / 512;
    bf16x8 qf[DH / 16];
#pragma unroll
    for (int d0 = 0; d0 < DH / 16; ++d0) qf[d0] = *(const bf16x8*)(qrow + d0 * 16 + hi * 8);
    const int qw0 = q0 + wid * 32, qpos = qw0 + r32;
    float m_run = 0.f, l_run = 0.f;
#pragma unroll
    for (int d = 0; d < 4; ++d)
#pragma unroll
        for (int r = 0; r < 16; ++r) o[d][r] = 0.f;
    const int NT = 4 * (qblk + 1);
    const int pg = r32 >> 3, phh = (r32 >> 2) & 1, pt = r32 & 3, prow = 16 * (pg >> 1) + 8 * phh + 4 * (pg & 1) + pt;
    const unsigned kfo = prow * KP + hi * 16, vfo = r32 * ATT_VP + hi * 16;
    u32x4 kreg[KLD], vreg[2];
#define TILE_OF(i) (MOBA ? ((((i) < 4) ? qblk : (((i) >> 2) - 1)) * 4 + ((i) & 3)) : (i))
#define LOADG(tile) do { const int kv0_ = (tile) * 64; \
        _Pragma("unroll") for (int j = 0; j < KLD; ++j) { const int p = tid + 512 * j, row = p / KPIECES, c = p % KPIECES; kreg[j] = *(const u32x4*)(kbase + (size_t)(kv0_ + row) * PJ_LD + c * 8); } \
        _Pragma("unroll") for (int j = 0; j < 2; ++j) { const int p = tid + 512 * j, d = p >> 3, c = p & 7; vreg[j] = *(const u32x4*)(vtbase + (size_t)d * VT_LD + kv0_ + c * 8); } } while (0)
#define STORE_LDS(buf) do { \
        _Pragma("unroll") for (int j = 0; j < KLD; ++j) { const int p = tid + 512 * j, row = p / KPIECES, c = p % KPIECES; *(LAS u32x4*)(lds + (buf) * ATT_LDS_KB + row * KP + c * 16) = kreg[j]; } \
        _Pragma("unroll") for (int j = 0; j < 2; ++j) { const int p = tid + 512 * j, d = p >> 3, c = p & 7; *(LAS u32x4*)(lds + ATT_LDS_V0 + (buf) * ATT_LDS_VB + d * ATT_VP + c * 16) = vreg[j]; } } while (0)
    LOADG(TILE_OF(0)); STORE_LDS(0); __syncthreads();
    if (wid >= 4) __builtin_amdgcn_s_setprio(1);
#pragma unroll 1
    for (int i = 0; i < NT; ++i) {
        const int tile = TILE_OF(i), kv0 = tile * 64, blk = tile >> 2, buf = i & 1;
        { const int in_ = (i + 1 < NT) ? i + 1 : i; LOADG(TILE_OF(in_)); }
        const bool diag = (blk == qblk);
        bool active = !(diag && kv0 > qw0 + 31);
        const bool mysel = MOBA ? (((sel >> blk) & 1u) != 0u) : true;
        if (MOBA && !diag) { if (!__any(mysel ? 1 : 0)) active = false; }
        if (active) {
            const LAS unsigned char* Kb = lds + buf * ATT_LDS_KB; const LAS unsigned char* Vb = lds + ATT_LDS_V0 + buf * ATT_LDS_VB;
            f32x16 s[2];
            const float fb = sl2 * (float)(kv0 + 8 * hi - qpos) - m_run;
            const int thr = qpos - kv0 - 8 * hi;
            const bool need = (diag && kv0 + 63 > qw0) || (MOBA && !diag && !__all(mysel ? 1 : 0));
            int thr_eff = diag ? thr : 4096;
            if (MOBA) thr_eff = (!diag && !mysel) ? -4096 : thr_eff;
            constexpr int NQK = DH / 16, PER = 16 / NQK;
            {
                const float fb0 = fb, fb1 = fb + sl2 * 16.0f;
#pragma unroll
                for (int r = 0; r < 16; ++r) s[0][r] = ((r >> 3) ? fb1 : fb0) + sl2 * (float)(r & 7);
            }
            const float fb2 = fb + sl2 * 32.0f, fb3 = fb + sl2 * 48.0f;
#pragma unroll
            for (int g0 = 0; g0 < NQK; g0 += 4) {
                bf16x8 kf[4];
#pragma unroll
                for (int j4 = 0; j4 < 4; ++j4) kf[j4] = *(const LAS bf16x8*)(Kb + kfo + (g0 + j4) * 32);
#pragma unroll
                for (int j4 = 0; j4 < 4; ++j4) { const int d0 = g0 + j4;
                    s[0] = MFMA32(kf[j4], qf[d0], s[0]);
#pragma unroll
                    for (int j = 0; j < PER; ++j) { const int r = d0 * PER + j; s[1][r] = ((r >> 3) ? fb3 : fb2) + sl2 * (float)(r & 7); }
                }
                __builtin_amdgcn_sched_barrier(0);
            }
            if (need) {
#pragma unroll
                for (int r = 0; r < 16; ++r) s[0][r] = (16 * (r >> 3) + (r & 7) > thr_eff) ? ATT_NEG : s[0][r];
            }
            float mx = fmaxf(fmaxf(s[0][0], s[0][1]), s[0][2]);
#pragma unroll
            for (int r = 3; r < 15; r += 2) mx = fmaxf(fmaxf(mx, s[0][r]), s[0][r + 1]);
            mx = fmaxf(mx, s[0][15]);
            __builtin_amdgcn_sched_barrier(0);
#pragma unroll
            for (int g0 = 0; g0 < NQK; g0 += 4) {
                bf16x8 kf[4];
#pragma unroll
                for (int j4 = 0; j4 < 4; ++j4) kf[j4] = *(const LAS bf16x8*)(Kb + kfo + 32 * KP + (g0 + j4) * 32);
#pragma unroll
                for (int j4 = 0; j4 < 4; ++j4) { const int d0 = g0 + j4;
                    s[1] = MFMA32(kf[j4], qf[d0], s[1]);
#pragma unroll
                    for (int j = 0; j < PER; ++j) { const int r = d0 * PER + j; s[0][r] = __builtin_amdgcn_exp2f(s[0][r]); asm volatile("" : "+v"(s[0][r])); }
                    __builtin_amdgcn_sched_barrier(0);
                }
            }
            if (need) {
#pragma unroll
                for (int r = 0; r < 16; ++r) s[1][r] = (32 + 16 * (r >> 3) + (r & 7) > thr_eff) ? ATT_NEG : s[1][r];
            }
            mx = fmaxf(fmaxf(mx, s[1][0]), s[1][1]);
#pragma unroll
            for (int r = 2; r < 16; r += 2) mx = fmaxf(fmaxf(mx, s[1][r]), s[1][r + 1]);
            mx = fmaxf(mx, __shfl_xor(mx, 32));
            if (__any(mx > 8.0f ? 1 : 0)) {
                const float dl = fmaxf(mx, 0.f), alpha = __builtin_amdgcn_exp2f(-dl);
                m_run += dl; l_run *= alpha;
#pragma unroll
                for (int d = 0; d < 4; ++d)
#pragma unroll
                    for (int r = 0; r < 16; ++r) o[d][r] *= alpha;
#pragma unroll
                for (int r = 0; r < 16; ++r) { s[0][r] *= alpha; s[1][r] -= dl; }
            }
#define PACK8(S, B) __builtin_bit_cast(bf16x8, (u32x4){cvt_pk_bf16(S[B], S[B + 1]), cvt_pk_bf16(S[B + 2], S[B + 3]), cvt_pk_bf16(S[B + 4], S[B + 5]), cvt_pk_bf16(S[B + 6], S[B + 7])})
            float lsum = 0.f;
#pragma unroll
            for (int r = 0; r < 16; ++r) lsum += s[0][r];
            bf16x8 pb[4];
            pb[0] = PACK8(s[0], 0); pb[1] = PACK8(s[0], 8);
            __builtin_amdgcn_sched_barrier(0);
#pragma unroll
            for (int c = 0; c < 2; ++c) {
                bf16x8 vf[4];
#pragma unroll
                for (int d = 0; d < 4; ++d) vf[d] = *(const LAS bf16x8*)(Vb + vfo + d * 32 * ATT_VP + c * 32);
#pragma unroll
                for (int d = 0; d < 4; ++d) { o[d] = MFMA32(vf[d], pb[c], o[d]);
                    s[1][(c * 4 + d) * 2] = __builtin_amdgcn_exp2f(s[1][(c * 4 + d) * 2]); s[1][(c * 4 + d) * 2 + 1] = __builtin_amdgcn_exp2f(s[1][(c * 4 + d) * 2 + 1]);
                    __builtin_amdgcn_sched_barrier(0); }
            }
            pb[2] = PACK8(s[1], 0); pb[3] = PACK8(s[1], 8);
            __builtin_amdgcn_sched_barrier(0);
#pragma unroll
            for (int c = 2; c < 4; ++c) {
                bf16x8 vf[4];
#pragma unroll
                for (int d = 0; d < 4; ++d) vf[d] = *(const LAS bf16x8*)(Vb + vfo + d * 32 * ATT_VP + c * 32);
#pragma unroll
                for (int d = 0; d < 4; ++d) { o[d] = MFMA32(vf[d], pb[c], o[d]);
                    lsum += s[1][((c - 2) * 4 + d) * 2] + s[1][((c - 2) * 4 + d) * 2 + 1];
                    __builtin_amdgcn_sched_barrier(0); }
            }
            l_run += lsum;
#undef PACK8
        }
        STORE_LDS((i + 1) & 1);
        __syncthreads();
    }
#undef TILE_OF
#undef LOADG
#undef STORE_LDS
    __builtin_amdgcn_s_setprio(0);
    const float lt = l_run + __shfl_xor(l_run, 32), inv = 1.0f / lt;
#pragma unroll
    for (int d = 0; d < 4; ++d)
#pragma unroll
        for (int r = 0; r < 16; ++r) o[d][r] *= inv;
}

#define XB_TMO      128
#define XB_XCNT(j)  (256  + 64 * (j))
#define XB_XSUB(j)  (1280 + 64 * (j))
#define XB_XGEN(j)  (2304 + 64 * (j))
#define XB_TOP      3328
#define XB_TOPGEN   3392
#define XCD_BAR_WORDS 3456
#define XB_SPIN_CAP (1u << 18)

__device__ __forceinline__ unsigned xb_ld(unsigned* p)              { return __hip_atomic_load(p, __ATOMIC_RELAXED, __HIP_MEMORY_SCOPE_AGENT); }
__device__ __forceinline__ unsigned xb_add(unsigned* p, unsigned v) { return __hip_atomic_fetch_add(p, v, __ATOMIC_RELAXED, __HIP_MEMORY_SCOPE_AGENT); }
__device__ __forceinline__ unsigned xb_xcc_id() { return (unsigned)__builtin_amdgcn_s_getreg((3 << 11) | 20) & 0xFu; }
#define XB_SPIN(cond, bar) do { unsigned _sp = 0; while (cond) { __builtin_amdgcn_s_sleep(1); \
    if ((++_sp & 255u) == 0u) { if (xb_ld(&(bar)[XB_TMO])) break; if (_sp > XB_SPIN_CAP) { atomicAdd(&(bar)[XB_TMO], 1u); break; } } } } while (0)

struct XcdBarrier {
    unsigned* bar; unsigned x;
    volatile LAS unsigned* st;
};

__device__ __forceinline__ XcdBarrier xcd_barrier_post(unsigned* bar, volatile LAS unsigned* st) {
    XcdBarrier b; b.bar = bar; b.x = xb_xcc_id(); b.st = st;
    if (threadIdx.x == 0) (void)xb_add(&bar[XB_XCNT(b.x)], 1u);
    return b;
}
__device__ __forceinline__ void xcd_barrier_complete(unsigned* bar, unsigned x, unsigned& nloc, unsigned& nx) {
    const unsigned G = gridDim.x * gridDim.y * gridDim.z;
    unsigned sum, cnt, mine, sp = 0u;
    for (;;) {
        sum = 0u; cnt = 0u; mine = 0u;
#pragma unroll
        for (unsigned j = 0; j < 16; ++j) { const unsigned c = xb_ld(&bar[XB_XCNT(j)]); sum += c; cnt += (c > 0u) ? 1u : 0u; mine = (j == x) ? c : mine; }
        if (sum == G) break;
        __builtin_amdgcn_s_sleep(1);
        if ((++sp & 255u) == 0u) { if (xb_ld(&bar[XB_TMO])) break; if (sp > XB_SPIN_CAP) { atomicAdd(&bar[XB_TMO], 1u); break; } }
    }
    nloc = mine > 0u ? mine : 1u; nx = cnt > 0u ? cnt : 1u;
}

__device__ __forceinline__ void xcd_barrier(const XcdBarrier& b) {
    asm volatile("s_waitcnt vmcnt(0)" ::: "memory");
    __syncthreads();
    if (threadIdx.x == 0) {
        unsigned* bar = b.bar;
        __builtin_amdgcn_s_waitcnt(0);
        unsigned nloc = b.st[0], nx = b.st[1];
        if (nloc == 0u) { xcd_barrier_complete(bar, b.x, nloc, nx); b.st[0] = nloc; b.st[1] = nx; }
        const unsigned old = xb_add(&bar[XB_XSUB(b.x)], 1u);
        const unsigned gen = old / nloc;
        if (old + 1u == (gen + 1u) * nloc) {
            __builtin_amdgcn_fence(__ATOMIC_RELEASE, "agent");
            asm volatile("s_waitcnt vmcnt(0)" ::: "memory");
            const unsigned og = xb_add(&bar[XB_TOP], 1u);
            const unsigned tg = og / nx;
            if (og + 1u == (tg + 1u) * nx) xb_add(&bar[XB_TOPGEN], 1u);
            else XB_SPIN(xb_ld(&bar[XB_TOPGEN]) == tg, bar);
            __builtin_amdgcn_fence(__ATOMIC_ACQUIRE, "agent");
            xb_add(&bar[XB_XGEN(b.x)], 1u);
            asm volatile("s_waitcnt vmcnt(0)" ::: "memory");
        } else {
            XB_SPIN(xb_ld(&bar[XB_XGEN(b.x)]) == gen, bar);
            __builtin_amdgcn_fence(__ATOMIC_ACQUIRE, "agent");
            asm volatile("s_waitcnt vmcnt(0)" ::: "memory");
        }
    }
    __syncthreads();
}

#ifndef PHASES
#define PHASES 0xFFFF
#endif
#ifndef DUP_MASK
#define DUP_MASK 0
#endif
#define REP(bit) _Pragma("unroll 1") for (int rep_ = 0; rep_ < 1 + ((DUP_MASK >> (bit)) & 1); ++rep_)
struct Args { const float* in[18]; float* out; unsigned char* ws; };

__global__ void __launch_bounds__(512, 2) mega_fwd(Args a) {
    extern __shared__ __attribute__((aligned(16))) unsigned char lds_raw[];
    LAS unsigned char* lds = (LAS unsigned char*)lds_raw;
    cg::grid_group grid = cg::this_grid();
    const int G = gridDim.x, NGW = G * 8;
    volatile LAS unsigned* bar_st = (volatile LAS unsigned*)(lds + LDS_BYTES - 64);
    if (threadIdx.x < 2) bar_st[threadIdx.x] = 0u;
    __syncthreads();
    const XcdBarrier xbar = xcd_barrier_post((unsigned*)(a.ws + WS_BAR), bar_st);
#define SEAM() xcd_barrier(xbar)
    if (a.out == nullptr) grid.sync();
#define PHASE_IDS() int tid_o = threadIdx.x; asm volatile("" : "+v"(tid_o)); const int tid = tid_o, lane = tid & 63, wave = __builtin_amdgcn_readfirstlane(tid >> 6), gw = blockIdx.x * 8 + wave; \
    LAS unsigned* scr = (LAS unsigned*)(lds + wave * 16896); (void)tid; (void)lane; (void)gw; (void)scr;
    unsigned char* ws = a.ws;
    float* SSQ0 = (float*)(ws + WS_SSQ0); float* SSQ1 = (float*)(ws + WS_SSQ1); float* SSQ2 = (float*)(ws + WS_SSQ2); float* SSQ3 = (float*)(ws + WS_SSQ3);
    float* KMEAN = (float*)(ws + WS_KMEAN);
    bf16_t* WGU = (bf16_t*)(ws + WS_WGU); bf16_t* WDN = (bf16_t*)(ws + WS_WDN); bf16_t* WGU1 = (bf16_t*)(ws + WS_WGU1); bf16_t* WDN1 = (bf16_t*)(ws + WS_WDN1); bf16_t* WIN = (bf16_t*)(ws + WS_WIN); bf16_t* WV = (bf16_t*)(ws + WS_WV);
    bf16_t* WPA = (bf16_t*)(ws + WS_WPA); bf16_t* WPB = (bf16_t*)(ws + WS_WPB); bf16_t* WO = (bf16_t*)(ws + WS_WO);
    bf16_t* XB = (bf16_t*)(ws + WS_XB); bf16_t* ACT = (bf16_t*)(ws + WS_ACT); bf16_t* OA = (bf16_t*)(ws + WS_OA); bf16_t* OB = (bf16_t*)(ws + WS_OB);
    bf16_t* PJ = (bf16_t*)(ws + WS_PJ); bf16_t* VT = (bf16_t*)(ws + WS_VT); bf16_t* MG = VT;
    float* STASH = (float*)(ws + WS_ACT + 32 * MiB);
    float* XR = a.out;

    if (PHASES & (1 << 0)) REP(0)
    {
        PHASE_IDS();
        constexpr int NI = 5632 + 1024 + 1024 + 2048 + 512 + 512 + 512 + 512 + 1024 + WGU2_EARLY;
#define P0_DESC(it_, D) do { int r = (it_); const float* W; int K, Nsrc, c0, nc, r0 = 0, mode = 0; bf16_t* WT; const float* g = nullptr; \
            if (r < 5632) { W = a.in[2]; K = 2048; Nsrc = 11264; c0 = 0; nc = 11264; WT = WGU1; g = a.in[1]; mode = 1; } \
            else if ((r -= 5632) < 1024) { W = a.in[5]; K = 2048; Nsrc = 10240; c0 = 0; nc = 2048; WT = WIN; r0 = 0; g = a.in[4]; } \
            else if ((r -= 1024) < 1024) { W = a.in[5]; K = 2048; Nsrc = 10240; c0 = 3072; nc = 2048; WT = WIN; r0 = 2048; g = a.in[4]; } \
            else if ((r -= 1024) < 2048) { W = a.in[5]; K = 2048; Nsrc = 10240; c0 = 6144; nc = 4096; WT = WIN; r0 = 4096; g = a.in[4]; } \
            else if ((r -= 2048) < 512) { W = a.in[5]; K = 2048; Nsrc = 10240; c0 = 2048; nc = 1024; WT = WV; r0 = 0; g = a.in[4]; } \
            else if ((r -= 512) < 512) { W = a.in[5]; K = 2048; Nsrc = 10240; c0 = 5120; nc = 1024; WT = WV; r0 = 1024; g = a.in[4]; } \
            else if ((r -= 512) < 512) { W = a.in[11]; K = 1024; Nsrc = 2048; c0 = 0; nc = 2048; WT = WPA; } \
            else if ((r -= 512) < 512) { W = a.in[12]; K = 1024; Nsrc = 2048; c0 = 0; nc = 2048; WT = WPB; } \
            else if ((r -= 512) < 1024) { W = a.in[13]; K = 2048; Nsrc = 2048; c0 = 0; nc = 2048; WT = WO; } \
            else { r -= 1024; W = a.in[15]; K = 2048; Nsrc = 11264; c0 = 0; nc = 11264; WT = WGU; g = a.in[14]; mode = 1; } \
            D = conv_desc(W, K, Nsrc, c0, nc, WT, r0, g, mode, r); } while (0)
        const bool skip_late = (G == 256);
        for (int it = gw; it < NI - (skip_late ? 7168 : 0); it += NGW) {
            ConvDesc A; P0_DESC(!skip_late ? it : (it < 5632 ? it : it + 7168), A);
            conv_pair(A, A, false, scr, lane);
        }
#undef P0_DESC
        const float* x = a.in[0];
        for (int row = gw; row < M_TOK; row += NGW) {
            const f32x4* xr = (const f32x4*)(x + (size_t)row * DMODEL) + lane; float s = 0.f;
            u32x2* ob = (u32x2*)(XB + (size_t)row * DMODEL) + lane;
            f32x4 xv[8];
#pragma unroll
            for (int j = 0; j < 8; ++j) xv[j] = __builtin_nontemporal_load(xr + 64 * j);
#pragma unroll
            for (int j = 0; j < 8; ++j) { const f32x4 v = xv[j]; s += (v[0] * v[0] + v[1] * v[1]) + (v[2] * v[2] + v[3] * v[3]); u32x2 w; w.x = cvt_pk_bf16(v[0], v[1]); w.y = cvt_pk_bf16(v[2], v[3]); ob[64 * j] = w; }
            s = wave_sum(s);
            if (lane < 32) SSQ0[(size_t)row * 32 + lane] = (lane == 0) ? s : 0.f;
        }
    }
    SEAM();

    if (PHASES & (1 << 1)) REP(1)
    {
    { Gemm g{XB, WGU1, M_TOK, 2 * DFF, DMODEL}; StaticOrder S; S.init(M_TOK, 2 * DFF, G, (int)blockIdx.x); EpiSwiglu E{ACT, DFF, SSQ0};
      gemm_phase<EpiSwiglu, StaticOrder, true, true>(lds, g, S, E); }
    {
        PHASE_IDS();
        const int nwg = (M_TOK / 256) * (2 * DFF / 256), rounds = (nwg + G - 1) / G, rem = nwg - (rounds - 1) * G;
        int first = gw, stride = NGW;
        if (rem < G) { first = ((int)blockIdx.x - rem) * 8 + wave; stride = (G - rem) * 8; if ((int)blockIdx.x < rem) first = 1 << 30; }
#define T1_DESC(it_, D) do { if ((it_) < 2816) D = conv_desc(a.in[3], 5632, 2048, 0, 2048, WDN1, 0, nullptr, 0, (it_)); \
            else if (G != 256) D = conv_desc(a.in[15], 2048, 11264, 0, 11264, WGU, 0, a.in[14], 1, (it_) - 2816 + WGU2_EARLY); \
            else if ((it_) < 2816 + 512) D = conv_desc(a.in[11], 1024, 2048, 0, 2048, WPA, 0, nullptr, 0, (it_) - 2816); \
            else if ((it_) < 2816 + 1024) D = conv_desc(a.in[12], 1024, 2048, 0, 2048, WPB, 0, nullptr, 0, (it_) - 2816 - 512); \
            else if ((it_) < 2816 + 2048) D = conv_desc(a.in[13], 2048, 2048, 0, 2048, WO, 0, nullptr, 0, (it_) - 2816 - 1024); \
            else if ((it_) < 2816 + 4096) D = conv_desc(a.in[5], 2048, 10240, 6144, 4096, WIN, 4096, a.in[4], 0, (it_) - 2816 - 2048); \
            else if ((it_) < 2816 + 5120) D = conv_desc(a.in[5], 2048, 10240, 0, 2048, WIN, 0, a.in[4], 0, (it_) - 2816 - 4096); \
            else if ((it_) < 2816 + 6144) D = conv_desc(a.in[5], 2048, 10240, 3072, 2048, WIN, 2048, a.in[4], 0, (it_) - 2816 - 5120); \
            else if ((it_) < 2816 + 6656) D = conv_desc(a.in[5], 2048, 10240, 2048, 1024, WV, 0, a.in[4], 0, (it_) - 2816 - 6144); \
            else D = conv_desc(a.in[5], 2048, 10240, 5120, 1024, WV, 1024, a.in[4], 0, (it_) - 2816 - 6656); } while (0)
        for (int it = first; it < (G == 256 ? 2816 + TAIL1_EXTRA : 2816 + 5632 - WGU2_EARLY); it += stride) {
            ConvDesc A; T1_DESC(it, A);
            conv_pair(A, A, false, scr, lane);
        }
#undef T1_DESC
        __syncthreads();
    }
    }
    SEAM();
    if ((DUP_MASK >> 17) & 1) { _Pragma("unroll 1") for (int q = 0; q < 20; ++q) SEAM(); }
    if (PHASES & (1 << 2)) REP(2)
    { Gemm g{ACT, WDN1, M_TOK, DMODEL, DFF}; StaticOrder S; S.init(M_TOK, DMODEL, G, (int)blockIdx.x); EpiRes E{a.in[0], XR, XB, SSQ1, 0.5f};
      gemm_phase<EpiRes, StaticOrder, true, true>(lds, g, S, E); }
    SEAM();
    if (PHASES & (1 << 3)) REP(3)
    {
    { Gemm g{XB, WIN, M_TOK, PJ_LD, DMODEL}; StaticOrder S; S.init(M_TOK, PJ_LD, G, (int)blockIdx.x); EpiProj E{PJ, PJ_LD, SSQ1, QA_SCALE, QB_SCALE, KMEAN};
      gemm_phase<EpiProj, StaticOrder, true, true>(lds, g, S, E); }
    { Gemm g{WV, XB, 2048, M_TOK, DMODEL}; StaticOrder S; S.init(2048, M_TOK, G, (int)blockIdx.x); EpiVt E{VT, VT_LD, SSQ1};
      gemm_phase<EpiVt, StaticOrder, true, true>(lds, g, S, E); }
    }
    SEAM();
    if (PHASES & (1 << 5)) REP(5)
    {
        float lam;
        { int l_o = threadIdx.x; asm volatile("" : "+v"(l_o)); const int lane = l_o & 63; const float p1 = wave_sum(a.in[6][lane] * a.in[7][lane]), p2 = wave_sum(a.in[8][lane] * a.in[9][lane]); lam = __uint_as_float(__builtin_amdgcn_readfirstlane(__float_as_uint(expf(p1) - expf(p2) + 0.2f))); }
        unsigned* cnt_u = (unsigned*)(a.ws + WS_BAR) + 3600; unsigned* cnt_c = (unsigned*)(a.ws + WS_BAR) + 3968;
        volatile LAS unsigned* wq = (volatile LAS unsigned*)(lds + LDS_BYTES - 128);
        const int xq = (int)(blockIdx.x & 7);
#ifndef ATT_DYNAMIC
#define ATT_DYNAMIC 0
#endif
#pragma unroll 1
        for (int ustat = blockIdx.x;; ustat += G) {
            int ucode, useq;
            if (ATT_DYNAMIC) {
                __syncthreads();
                if (threadIdx.x == 0) wq[0] = __hip_atomic_fetch_add(cnt_u + 16 * xq, 1u, __ATOMIC_RELAXED, __HIP_MEMORY_SCOPE_AGENT);
                __syncthreads();
                const int useq8 = __builtin_amdgcn_readfirstlane((int)wq[0]);
                if (useq8 >= 64) break;
                ucode = (int)((0x809A1B2CD3E4F567ull >> (4 * (useq8 >> 2))) & 15ull);
                useq = (useq8 & 3) * 8 + xq;
            } else {
                if (G == 256) {
                    const int k = (int)blockIdx.x >> 5, ui = (ustat - (int)blockIdx.x) >> 8;
                    const int nu = (k == 0) ? 1 : (k == 7 ? 3 : 2);
                    if (ui >= nu * (1 + ((DUP_MASK >> 16) & 1))) break;
                    const unsigned codes = (k == 0) ? 0x007u : (k == 1) ? 0x006u : (k == 2) ? 0x015u : (k == 3) ? 0x024u : (k == 4) ? 0x0D3u : (k == 5) ? 0x0BFu : (k == 6) ? 0x0CEu : 0x89Au;
                    ucode = (int)((codes >> (4 * (ui % nu))) & 15u); useq = (int)blockIdx.x & 31;
                } else {
                if (ustat >= 512 * (1 + ((DUP_MASK >> 16) & 1))) break;
                const int us = ustat & 511;
                useq = us & 31; ucode = us < 256 ? (us >> 5) : (8 | (7 - ((us - 256) >> 5)));
                }
            }
            int tid_o = threadIdx.x; asm volatile("" : "+v"(tid_o));
            const int tid = tid_o, lane = tid & 63, r32 = lane & 31, hi = lane >> 5, wave = __builtin_amdgcn_readfirstlane(tid >> 6);
#ifndef TEST_ATT
#define TEST_ATT 3
#endif
            if (ucode < 8) { if (TEST_ATT & 1) {
                const int qblk = ucode & 7, bh = useq & 31, b = bh >> 3, h = bh & 7, q0 = qblk * 256;
                const float sl2 = exp2f(-(float)(h + 1)) * LOG2E;
                const size_t row = (size_t)b * SEQ + q0 + wave * 32 + r32;
                f32x16 o[4];
                f32x4* stash = (f32x4*)(STASH + ((size_t)blockIdx.x * 512 + tid) * 64);
#pragma unroll 1
                for (int mp = 0; mp < 2; ++mp) {
                    flash_pass<64, false>(lds, PJ + row * PJ_LD + h * 128 + mp * 64, PJ + (size_t)b * SEQ * PJ_LD + 1024 + h * 128 + mp * 64, VT + (size_t)(h * 128) * VT_LD + (size_t)b * SEQ, q0, qblk, sl2, 0u, o, tid);
                    if (mp == 0) {
#pragma unroll
                        for (int d = 0; d < 4; ++d)
#pragma unroll
                            for (int g4 = 0; g4 < 4; ++g4) stash[d * 4 + g4] = (f32x4){o[d][4 * g4], o[d][4 * g4 + 1], o[d][4 * g4 + 2], o[d][4 * g4 + 3]}; }
                }
                float ss = 0.f;
#pragma unroll
                for (int d = 0; d < 4; ++d) {
#pragma unroll
                    for (int g4 = 0; g4 < 4; ++g4) { const f32x4 s0 = stash[d * 4 + g4];
#pragma unroll
                        for (int j = 0; j < 4; ++j) { const float v = s0[j] - lam * o[d][4 * g4 + j]; o[d][4 * g4 + j] = v; ss += v * v; } }
                    __builtin_amdgcn_sched_barrier(0); }
                ss += __shfl_xor(ss, 32);
                const float rinv = rsqrtf(ss * (1.0f / 128.0f) + RMS_EPS) * 0.8f;
                bf16_t* op = OA + row * 1024 + h * 128;
#pragma unroll
                for (int d = 0; d < 4; ++d)
#pragma unroll
                    for (int g4 = 0; g4 < 4; ++g4) { const int dd = 32 * d + 8 * g4 + 4 * hi; const f32x4 gs = *(const f32x4*)(a.in[10] + dd);
                        u32x2 w; w.x = cvt_pk_bf16(o[d][4 * g4 + 0] * rinv * gs[0], o[d][4 * g4 + 1] * rinv * gs[1]); w.y = cvt_pk_bf16(o[d][4 * g4 + 2] * rinv * gs[2], o[d][4 * g4 + 3] * rinv * gs[3]);
                        *(u32x2*)(op + dd) = w; }
            } } else if (TEST_ATT & 2) {
                const int qblk = ucode & 7, bh = useq & 31, b = bh >> 3, h = bh & 7, q0 = qblk * 256;
                const float sl2 = exp2f(-(float)(h + 1)) * LOG2E;
                const size_t row = (size_t)b * SEQ + q0 + wave * 32 + r32;
                const bf16_t* qp = PJ + row * PJ_LD + 2048 + h * 128;
                unsigned sel = 0u;
                if (qblk <= 3) sel = (1u << qblk) - 1u;
                else {
                    float qv[64];
#pragma unroll
                    for (int i = 0; i < 8; ++i) { const u32x4 w = *(const u32x4*)(qp + 64 * hi + 8 * i);
                        qv[8 * i + 0] = bf_lo(w.x); qv[8 * i + 1] = bf_hi(w.x); qv[8 * i + 2] = bf_lo(w.y); qv[8 * i + 3] = bf_hi(w.y); qv[8 * i + 4] = bf_lo(w.z); qv[8 * i + 5] = bf_hi(w.z); qv[8 * i + 6] = bf_lo(w.w); qv[8 * i + 7] = bf_hi(w.w); }
                    LAS float* kml = (LAS float*)(lds + 73728);
                    for (int idx = tid; idx < qblk * 128; idx += 512) { const float* kp = KMEAN + (size_t)(b * 8 + (idx >> 7)) * 2048 + h * 128 + (idx & 127); kml[idx] = kp[0] + kp[1024]; }
                    __syncthreads();
                    float gs[7];
#pragma unroll
                    for (int j = 0; j < 7; ++j) { gs[j] = 0.f;
                        if (j < qblk) { const LAS f32x4* km = (const LAS f32x4*)(kml + j * 128 + 64 * hi); float acc = 0.f;
#pragma unroll
                            for (int i = 0; i < 16; ++i) { const f32x4 k4 = km[i]; acc += qv[4 * i] * k4[0] + qv[4 * i + 1] * k4[1] + qv[4 * i + 2] * k4[2] + qv[4 * i + 3] * k4[3]; }
                            gs[j] = acc + __shfl_xor(acc, 32); }
                        __builtin_amdgcn_sched_barrier(0); }
#pragma unroll
                    for (int t = 0; t < 3; ++t) { float best = -INFINITY; int bi = 0;
#pragma unroll
                        for (int j = 0; j < 7; ++j) { if (j < qblk && !((sel >> j) & 1u) && gs[j] > best) { best = gs[j]; bi = j; } }
                        sel |= 1u << bi; }
                }
                f32x16 o[4];
                flash_pass<128, true>(lds, qp, PJ + (size_t)b * SEQ * PJ_LD + 3072 + h * 128, VT + (size_t)(1024 + h * 128) * VT_LD + (size_t)b * SEQ, q0, qblk, sl2, sel, o, tid);
                bf16_t* op = OB + row * 1024 + h * 128;
#pragma unroll
                for (int d = 0; d < 4; ++d)
#pragma unroll
                    for (int g4 = 0; g4 < 4; ++g4) { const int dd = 32 * d + 8 * g4 + 4 * hi;
                        u32x2 w; w.x = cvt_pk_bf16(o[d][4 * g4 + 0], o[d][4 * g4 + 1]); w.y = cvt_pk_bf16(o[d][4 * g4 + 2], o[d][4 * g4 + 3]);
                        *(u32x2*)(op + dd) = w; }
            }
        }
        if (G == 256 && ((int)blockIdx.x >> 5) == 7) {
            PHASE_IDS();
            __syncthreads();
            for (int it = WGU2_EARLY + ((int)blockIdx.x & 31) * 8 + wave; it < 5632; it += 256) {
                const ConvDesc A = conv_desc(a.in[15], 2048, 11264, 0, 11264, WGU, 0, a.in[14], 1, it);
                conv_pair(A, A, false, scr, lane);
            }
            __syncthreads();
        }
        if (ATT_DYNAMIC) {
            PHASE_IDS();
#pragma unroll 1
            for (;;) {
                unsigned itv = 0u; if (lane == 0) itv = __hip_atomic_fetch_add(cnt_c, 1u, __ATOMIC_RELAXED, __HIP_MEMORY_SCOPE_AGENT);
                const int it = __builtin_amdgcn_readfirstlane((int)itv);
                if (it >= 5632) break;
                const ConvDesc A = conv_desc(a.in[15], 2048, 11264, 0, 11264, WGU, 0, a.in[14], 1, it);
                conv_pair(A, A, false, scr, lane);
            }
        }
    }
    SEAM();
    if (PHASES & (1 << 6)) REP(6)
    {
    { Gemm g{OA, WPA, M_TOK, DMODEL, 1024}; StaticOrder S; S.init(M_TOK, DMODEL, G, (int)blockIdx.x); EpiGate<true> E{MG, PJ + 4096, PJ_LD};
      gemm_phase<EpiGate<true>, StaticOrder, true, true>(lds, g, S, E); }
    { Gemm g{OB, WPB, M_TOK, DMODEL, 1024}; StaticOrder S; S.init(M_TOK, DMODEL, G, (int)blockIdx.x); EpiGate<false> E{MG, PJ + 6144, PJ_LD};
      gemm_phase<EpiGate<false>, StaticOrder, true, true>(lds, g, S, E); }
    }
    SEAM();
    if (PHASES & (1 << 7)) REP(7)
    { Gemm g{MG, WO, M_TOK, DMODEL, DMODEL}; StaticOrder S; S.init(M_TOK, DMODEL, G, (int)blockIdx.x); EpiRes E{XR, XR, XB, SSQ2, 1.0f};
      gemm_phase<EpiRes, StaticOrder, true, true>(lds, g, S, E); }
    SEAM();
    if (PHASES & (1 << 8)) REP(8)
    {
    { Gemm g{XB, WGU, M_TOK, 2 * DFF, DMODEL}; StaticOrder S; S.init(M_TOK, 2 * DFF, G, (int)blockIdx.x); EpiSwiglu E{ACT, DFF, SSQ2};
      gemm_phase<EpiSwiglu, StaticOrder, true, true>(lds, g, S, E); }
    {
        PHASE_IDS();
        const int nwg = (M_TOK / 256) * (2 * DFF / 256), rounds = (nwg + G - 1) / G, rem = nwg - (rounds - 1) * G;
        int first = gw, stride = NGW;
        if (rem < G) { first = ((int)blockIdx.x - rem) * 8 + wave; stride = (G - rem) * 8; if ((int)blockIdx.x < rem) first = 1 << 30; }
        for (int it = first; it < 2816; it += stride) {
            const ConvDesc A = conv_desc(a.in[16], 5632, 2048, 0, 2048, WDN, 0, nullptr, 0, it);
            conv_pair(A, A, false, scr, lane);
        }
        __syncthreads();
    }
    }
    SEAM();
    if (G == 256) {
        Gemm g{ACT, WDN, M_TOK, DMODEL, DFF}; StaticOrder S; S.init(M_TOK, DMODEL, G, (int)blockIdx.x);
        EpiResNorm E{XR, XR, a.in[17], 0.5f, (float*)(ws + WS_XS), (unsigned*)(ws + WS_BAR) + 4096};
        gemm_phase<EpiResNorm, StaticOrder, false, true>(lds, g, S, E);
    } else {
    { Gemm g{ACT, WDN, M_TOK, DMODEL, DFF}; StaticOrder S; S.init(M_TOK, DMODEL, G, (int)blockIdx.x); EpiRes E{XR, XR, nullptr, SSQ3, 0.5f};
      gemm_phase<EpiRes, StaticOrder, true, true>(lds, g, S, E); }
    SEAM();
    {
        PHASE_IDS();
        const f32x4* gf = (const f32x4*)a.in[17] + lane;
        for (int row = gw; row < M_TOK; row += NGW) {
            const float rs = row_rstd(SSQ3, row);
            f32x4* xr = (f32x4*)(XR + (size_t)row * DMODEL) + lane;
            f32x4 xv[8];
#pragma unroll
            for (int j = 0; j < 8; ++j) xv[j] = xr[64 * j];
#pragma unroll
            for (int j = 0; j < 8; ++j) xr[64 * j] = xv[j] * rs * gf[64 * j];
        }
    }
    }
}

extern "C" void kernel_launch(void* const* d_in, const int* in_sizes, int n_in, void* d_out, int out_size, void* d_ws, size_t ws_size, hipStream_t stream) {
    static int grid_blocks = 0;
    if (grid_blocks == 0) {
        if (n_in != 18 || out_size != M_TOK * DMODEL || ws_size < WS_END) { fprintf(stderr, "kernel_launch: unexpected shapes (n_in %d out %d ws %zu)\n", n_in, out_size, ws_size); grid_blocks = -1; return; }
        int dev = 0, cus = 0, per_cu = 0;
        (void)hipGetDevice(&dev);
        (void)hipDeviceGetAttribute(&cus, hipDeviceAttributeMultiprocessorCount, dev);
        (void)hipFuncSetAttribute((const void*)mega_fwd, hipFuncAttributeMaxDynamicSharedMemorySize, LDS_BYTES);
        (void)hipOccupancyMaxActiveBlocksPerMultiprocessor(&per_cu, (const void*)mega_fwd, 512, LDS_BYTES);
        if (per_cu < 1) { fprintf(stderr, "kernel_launch: occupancy query says %d blocks per CU\n", per_cu); per_cu = 1; }
        grid_blocks = cus < 256 ? cus : 256;
        (void)hipGetLastError();
    }
    if (grid_blocks < 0) return;
    (void)hipMemsetAsync((unsigned char*)d_ws + WS_BAR, 0, BAR_BYTES, stream);
    Args a{};
    for (int i = 0; i < 18; ++i) a.in[i] = (const float*)d_in[i];
    a.out = (float*)d_out; a.ws = (unsigned char*)d_ws;
    void* args[] = {&a};
    hipError_t e = hipLaunchCooperativeKernel((const void*)mega_fwd, dim3(grid_blocks), dim3(512), args, LDS_BYTES, stream);
    if (e != hipSuccess) fprintf(stderr, "cooperative launch failed: %s (grid %d)\n", hipGetErrorString(e), grid_blocks);
}
```

```cpp
#include <hip/hip_runtime.h>
#include <hip/hip_cooperative_groups.h>
#include <cstdio>
#include <cstdint>
#include <cmath>
namespace cg = cooperative_groups;
namespace pg8 {
#define PG8_LAS __attribute__((address_space(3)))
typedef unsigned short bf16_t;
typedef short bf16x8 __attribute__((ext_vector_type(8)));
typedef float f32x4 __attribute__((ext_vector_type(4)));
typedef unsigned u32x4 __attribute__((ext_vector_type(4)));
constexpr int BM = 256, BK = 64, HALF = 128, HTB = HALF * BK * 2  , STAGE_BYTES = 8 * HTB, NXCD = 8, WGM = 8;

__host__ __device__ __forceinline__ int lds_byte(int r, int c) { const int st = (r >> 4) * 2 + (c >> 5), rr = r & 15, cc = c & 31, ob = rr * 64 + cc * 2; return st * 1024 + (ob ^ (((ob >> 9) & 1) << 5)); }
__host__ __device__ __forceinline__ void stage_rc(int b, int& R, int& C) { const int st = b / 1024, sb = b % 1024, swz = sb ^ (((sb >> 9) & 1) << 5); R = (st >> 1) * 16 + swz / 64; C = (st & 1) * 32 + (swz % 64) / 2; }
__host__ __device__ __forceinline__ int perm32(int rho) { const int n = rho >> 4, i = rho & 15; return 8 * (i >> 2) + 4 * n + (i & 3); }

struct Unit { int pm, pn; };
struct Gemm { const bf16_t* A; const bf16_t* Bt; int M, N, K; };

struct StaticOrder {
    int nM, nN, nwg, G, c;
    __host__ __device__ void init(int M, int N, int G_, int c_) { nM = M / BM; nN = N / BM; nwg = nM * nN; G = G_; c = c_; }
    __host__ __device__ bool next(int i, Unit& u) const {
        const long L = (long)i * G + c; if (L >= nwg) return false;
        int wgid = (int)L; { const int q = nwg / NXCD, r = nwg % NXCD, xcd = wgid % NXCD, off = wgid / NXCD; wgid = (xcd < r ? xcd * (q + 1) : r * (q + 1) + (xcd - r) * q) + off; }
        const int nig = WGM * nN, gid = wgid / nig, fm = gid * WGM, gsz = (nM - fm) < WGM ? (nM - fm) : WGM;
        u.pm = fm + ((wgid % nig) % gsz); u.pn = (wgid % nig) / gsz; return true;
    }
    __device__ __forceinline__ void a_ready(const Unit&) const {}
    __device__ __forceinline__ void done(const Unit&) const {}
};


typedef float f32x2 __attribute__((ext_vector_type(2)));
typedef unsigned u32x2 __attribute__((ext_vector_type(2)));
typedef __bf16 bf16x2_t __attribute__((ext_vector_type(2)));
__device__ __forceinline__ unsigned cvt_pk_bf16(float lo, float hi) { f32x2 v = {lo, hi}; bf16x2_t b = __builtin_convertvector(v, bf16x2_t); return __builtin_bit_cast(unsigned, b); }
__device__ __forceinline__ float bf_lo(unsigned u) { return __uint_as_float(u << 16); }
__device__ __forceinline__ float bf_hi(unsigned u) { return __uint_as_float(u & 0xffff0000u); }
constexpr int DMODEL = 2048;
constexpr float RMS_EPS = 1e-6f;
constexpr float LOG2E = 1.4426950408889634f;
__device__ __forceinline__ float row_rstd(const float* ssq, int row) {
    const f32x4* p = (const f32x4*)(ssq + (size_t)row * 32);
    float s = 0.f;
#pragma unroll
    for (int i = 0; i < 8; ++i) { const f32x4 v = p[i]; s += (v[0] + v[1]) + (v[2] + v[3]); }
    return __builtin_amdgcn_rsqf(s * (1.0f / DMODEL) + RMS_EPS);
}
__device__ __forceinline__ void rows_rstd(const float* ssq, int row0, int fq, float scale, float (&rs)[2][4]) {
    f32x4 pa[2][4], pb[2][4];
#pragma unroll
    for (int ai = 0; ai < 2; ++ai)
#pragma unroll
        for (int m = 0; m < 4; ++m) { const f32x4* p = (const f32x4*)(ssq + (size_t)(row0 + ai * HALF + m * 16) * 32 + 8 * fq); pa[ai][m] = p[0]; pb[ai][m] = p[1]; }
#pragma unroll
    for (int ai = 0; ai < 2; ++ai)
#pragma unroll
        for (int m = 0; m < 4; ++m) { const f32x4 a = pa[ai][m], c = pb[ai][m]; float s = ((a[0] + a[1]) + (a[2] + a[3])) + ((c[0] + c[1]) + (c[2] + c[3]));
            s += __shfl_xor(s, 16); s += __shfl_xor(s, 32); rs[ai][m] = __builtin_amdgcn_rsqf(s * (1.0f / DMODEL) + RMS_EPS) * scale; }
}
__device__ __forceinline__ float silu_f(float x) { return x * __builtin_amdgcn_rcpf(1.0f + __builtin_amdgcn_exp2f(-x * LOG2E)); }
__device__ __forceinline__ float sigmoid_f(float x) { return __builtin_amdgcn_rcpf(1.0f + __builtin_amdgcn_exp2f(-x * LOG2E)); }

struct EpiSwiglu {
    static constexpr bool PERM = true, AFTER_DRAIN = false;
    bf16_t* O; int ldo; const float* ssq;
    __device__ __forceinline__ void operator()(const f32x4 (&acc)[2][2][4][2], const Unit& u, int wr, int wc, int fr, int fq) const {
        const int row0 = u.pm * BM + wr * 64 + fr, col0 = u.pn * HALF + wc * 32 + 8 * fq;
        float rs[2][4];
        rows_rstd(ssq, row0, fq, 1.0f, rs);
#pragma unroll
        for (int ai = 0; ai < 2; ++ai)
#pragma unroll
            for (int m = 0; m < 4; ++m) { const int row = row0 + ai * HALF + m * 16; const float r = rs[ai][m];
                const f32x4 g0 = acc[ai][0][m][0] * r, g1 = acc[ai][0][m][1] * r, u0 = acc[ai][1][m][0] * r, u1 = acc[ai][1][m][1] * r;
                u32x4 w;
                w.x = cvt_pk_bf16(silu_f(g0[0]) * u0[0], silu_f(g0[1]) * u0[1]); w.y = cvt_pk_bf16(silu_f(g0[2]) * u0[2], silu_f(g0[3]) * u0[3]);
                w.z = cvt_pk_bf16(silu_f(g1[0]) * u1[0], silu_f(g1[1]) * u1[1]); w.w = cvt_pk_bf16(silu_f(g1[2]) * u1[2], silu_f(g1[3]) * u1[3]);
                *(u32x4*)(O + (size_t)row * ldo + col0) = w; }
    }
};
struct EpiRes {
    static constexpr bool PERM = false, AFTER_DRAIN = false;
    const float* base; float* out; bf16_t* outb; float* ssq_out; float alpha;
    __device__ __forceinline__ void operator()(const f32x4 (&acc)[2][2][4][2], const Unit& u, int wr, int wc, int fr, int fq) const {
        const int row0 = u.pm * BM + wr * 64 + fr, col0 = u.pn * BM + wc * 32 + 4 * fq;
#pragma unroll
        for (int ai = 0; ai < 2; ++ai) {
            f32x4 bs[4][2][2];
#pragma unroll
            for (int m = 0; m < 4; ++m)
#pragma unroll
                for (int bj = 0; bj < 2; ++bj)
#pragma unroll
                    for (int n = 0; n < 2; ++n) bs[m][bj][n] = *(const f32x4*)(base + (size_t)(row0 + ai * HALF + m * 16) * DMODEL + col0 + bj * HALF + n * 16);
#pragma unroll
            for (int m = 0; m < 4; ++m) { const int row = row0 + ai * HALF + m * 16; const size_t off = (size_t)row * DMODEL + col0; float sq = 0.f;
#pragma unroll
                for (int bj = 0; bj < 2; ++bj)
#pragma unroll
                    for (int n = 0; n < 2; ++n) { const size_t o2 = off + bj * HALF + n * 16; const f32x4 o = bs[m][bj][n] + acc[ai][bj][m][n] * alpha;
                        *(f32x4*)(out + o2) = o; sq += (o[0] * o[0] + o[1] * o[1]) + (o[2] * o[2] + o[3] * o[3]);
                        if (outb) { u32x2 w; w.x = cvt_pk_bf16(o[0], o[1]); w.y = cvt_pk_bf16(o[2], o[3]); *(u32x2*)(outb + o2) = w; } }
                sq += __shfl_xor(sq, 16); sq += __shfl_xor(sq, 32);
                if (fq == 0) ssq_out[(size_t)row * 32 + u.pn * 4 + wc] = sq; }
        }
    }
};
struct EpiProj {
    static constexpr bool PERM = true, AFTER_DRAIN = false;
    bf16_t* O; int ldo; const float* ssq; float qa_scale, qb_scale; float* kpart;
    __device__ __forceinline__ void operator()(const f32x4 (&acc)[2][2][4][2], const Unit& u, int wr, int wc, int fr, int fq) const {
        const int row0 = u.pm * BM + wr * 64 + fr, col0 = u.pn * BM + wc * 32 + 8 * fq;
        const bool sig = u.pn >= 16; const float sc = u.pn < 4 ? qa_scale : ((u.pn >= 8 && u.pn < 12) ? qb_scale : 1.0f);
        float rs[2][4];
        rows_rstd(ssq, row0, fq, sc, rs);
#pragma unroll
        for (int ai = 0; ai < 2; ++ai)
#pragma unroll
            for (int m = 0; m < 4; ++m) { const int row = row0 + ai * HALF + m * 16; const float r = rs[ai][m];
#pragma unroll
                for (int bj = 0; bj < 2; ++bj) { f32x4 v0 = acc[ai][bj][m][0] * r, v1 = acc[ai][bj][m][1] * r;
                    if (sig) {
#pragma unroll
                        for (int j = 0; j < 4; ++j) { v0[j] = sigmoid_f(v0[j]); v1[j] = sigmoid_f(v1[j]); } }
                    u32x4 w; w.x = cvt_pk_bf16(v0[0], v0[1]); w.y = cvt_pk_bf16(v0[2], v0[3]); w.z = cvt_pk_bf16(v1[0], v1[1]); w.w = cvt_pk_bf16(v1[2], v1[3]);
                    *(u32x4*)(O + (size_t)row * ldo + col0 + bj * HALF) = w; } }
        if (u.pn >= 12 && u.pn < 16) {
#pragma unroll
            for (int bj = 0; bj < 2; ++bj) { f32x4 s0 = {0.f, 0.f, 0.f, 0.f}, s1 = {0.f, 0.f, 0.f, 0.f};
#pragma unroll
                for (int ai = 0; ai < 2; ++ai)
#pragma unroll
                    for (int m = 0; m < 4; ++m) { s0 += acc[ai][bj][m][0] * rs[ai][m]; s1 += acc[ai][bj][m][1] * rs[ai][m]; }
#pragma unroll
                for (int j = 0; j < 4; ++j) {
#pragma unroll
                    for (int o = 1; o < 16; o <<= 1) { s0[j] += __shfl_xor(s0[j], o); s1[j] += __shfl_xor(s1[j], o); } }
                if (fr == 0) { float* kp = kpart + ((size_t)u.pm * 2 + wr) * 1024 + (col0 - 3072) + bj * HALF; *(f32x4*)kp = s0; *(f32x4*)(kp + 4) = s1; } }
        }
    }
};
struct EpiVt {
    static constexpr bool PERM = true, AFTER_DRAIN = false;
    bf16_t* O; int ldo; const float* ssq;
    __device__ __forceinline__ void operator()(const f32x4 (&acc)[2][2][4][2], const Unit& u, int wr, int wc, int fr, int fq) const {
        const int row0 = u.pm * BM + wr * 64 + fr, col0 = u.pn * BM + wc * 32 + 8 * fq;
        f32x4 rs[2][2];
        {
            const float mine = row_rstd(ssq, u.pn * BM + (fr >> 3) * HALF + wc * 32 + 8 * fq + (fr & 7));
            const int lbase = fq * 16;
#pragma unroll
            for (int bj = 0; bj < 2; ++bj)
#pragma unroll
                for (int n = 0; n < 2; ++n)
#pragma unroll
                    for (int j = 0; j < 4; ++j) rs[bj][n][j] = __shfl(mine, lbase + bj * 8 + n * 4 + j);
        }
#pragma unroll
        for (int ai = 0; ai < 2; ++ai)
#pragma unroll
            for (int m = 0; m < 4; ++m) { const int row = row0 + ai * HALF + m * 16;
#pragma unroll
                for (int bj = 0; bj < 2; ++bj) { const f32x4 v0 = acc[ai][bj][m][0] * rs[bj][0], v1 = acc[ai][bj][m][1] * rs[bj][1];
                    u32x4 w; w.x = cvt_pk_bf16(v0[0], v0[1]); w.y = cvt_pk_bf16(v0[2], v0[3]); w.z = cvt_pk_bf16(v1[0], v1[1]); w.w = cvt_pk_bf16(v1[2], v1[3]);
                    *(u32x4*)(O + (size_t)row * ldo + col0 + bj * HALF) = w; } }
    }
};
template <bool FIRST> struct EpiGate {
    static constexpr bool PERM = true, AFTER_DRAIN = false;
    bf16_t* T; const bf16_t* sig; int ldsig;
    __device__ __forceinline__ void operator()(const f32x4 (&acc)[2][2][4][2], const Unit& u, int wr, int wc, int fr, int fq) const {
        const int row0 = u.pm * BM + wr * 64 + fr, col0 = u.pn * BM + wc * 32 + 8 * fq;
#pragma unroll
        for (int ai = 0; ai < 2; ++ai) {
            u32x4 sg[4][2], tt[4][2];
#pragma unroll
            for (int m = 0; m < 4; ++m)
#pragma unroll
                for (int bj = 0; bj < 2; ++bj) { const int row = row0 + ai * HALF + m * 16, col = col0 + bj * HALF;
                    sg[m][bj] = *(const u32x4*)(sig + (size_t)row * ldsig + col);
                    if (!FIRST) tt[m][bj] = *(const u32x4*)(T + (size_t)row * DMODEL + col); }
#pragma unroll
            for (int m = 0; m < 4; ++m) { const int row = row0 + ai * HALF + m * 16;
#pragma unroll
                for (int bj = 0; bj < 2; ++bj) { const int col = col0 + bj * HALF;
                    const u32x4 s = sg[m][bj];
                    const f32x4 a0 = acc[ai][bj][m][0], a1 = acc[ai][bj][m][1];
                    float v[8];
                    v[0] = bf_lo(s.x) * a0[0]; v[1] = bf_hi(s.x) * a0[1]; v[2] = bf_lo(s.y) * a0[2]; v[3] = bf_hi(s.y) * a0[3];
                    v[4] = bf_lo(s.z) * a1[0]; v[5] = bf_hi(s.z) * a1[1]; v[6] = bf_lo(s.w) * a1[2]; v[7] = bf_hi(s.w) * a1[3];
                    bf16_t* tp = T + (size_t)row * DMODEL + col;
                    if (!FIRST) { const u32x4 t = tt[m][bj];
                        v[0] += bf_lo(t.x); v[1] += bf_hi(t.x); v[2] += bf_lo(t.y); v[3] += bf_hi(t.y); v[4] += bf_lo(t.z); v[5] += bf_hi(t.z); v[6] += bf_lo(t.w); v[7] += bf_hi(t.w); }
                    u32x4 w; w.x = cvt_pk_bf16(v[0], v[1]); w.y = cvt_pk_bf16(v[2], v[3]); w.z = cvt_pk_bf16(v[4], v[5]); w.w = cvt_pk_bf16(v[6], v[7]);
                    *(u32x4*)tp = w; } }
        }
    }
};

struct PairOrder {
    StaticOrder s;
    __device__ __forceinline__ bool next(int i, Unit& u) const { Unit t; if (!s.next(i >> 1, t)) return false; const int o = i & 1; u.pm = t.pm + 32 * o; u.pn = t.pn + 8 * o; return true; }
    __device__ __forceinline__ void a_ready(const Unit&) const {}
    __device__ __forceinline__ void done(const Unit&) const {}
};
struct EpiGatePair {
    static constexpr bool PERM = true, AFTER_DRAIN = false;
    bf16_t* T; const bf16_t* pj; int ldsig;
    __device__ __forceinline__ void operator()(const f32x4 (&acc)[2][2][4][2], const Unit& u, int wr, int wc, int fr, int fq) const {
        if (u.pm < 32) { const EpiGate<true> e{T, pj + 4096, ldsig}; e(acc, u, wr, wc, fr, fq); }
        else { Unit v; v.pm = u.pm - 32; v.pn = u.pn - 8; const EpiGate<false> e{T, pj + 6144, ldsig}; e(acc, v, wr, wc, fr, fq); }
    }
};

struct EpiResNorm {
    static constexpr bool PERM = false, AFTER_DRAIN = true;
    const float* base; float* out; const float* gain; float alpha; float* xs; unsigned* cnt;
    __device__ __forceinline__ void operator()(const f32x4 (&)[2][2][4][2], const Unit&, int, int, int, int) const {}
    __device__ __forceinline__ void fused(f32x4 (&acc)[2][2][4][2], const Unit& u, int wr, int wc, int fr, int fq, PG8_LAS unsigned char* lds, int wid, int lane) const {
        PG8_LAS float* P = (PG8_LAS float*)lds;
        PG8_LAS float* S = (PG8_LAS float*)(lds + 8192);
        const int row0 = u.pm * BM + wr * 64 + fr, col0 = u.pn * BM + wc * 32 + 4 * fq;
#pragma unroll
        for (int ai = 0; ai < 2; ++ai) {
            f32x4 bs[4][2][2];
#pragma unroll
            for (int m = 0; m < 4; ++m)
#pragma unroll
                for (int bj = 0; bj < 2; ++bj)
#pragma unroll
                    for (int n = 0; n < 2; ++n) bs[m][bj][n] = *(const f32x4*)(base + (size_t)(row0 + ai * HALF + m * 16) * DMODEL + col0 + bj * HALF + n * 16);
#pragma unroll
            for (int m = 0; m < 4; ++m) { float sq = 0.f;
#pragma unroll
                for (int bj = 0; bj < 2; ++bj)
#pragma unroll
                    for (int n = 0; n < 2; ++n) { const f32x4 o = bs[m][bj][n] + acc[ai][bj][m][n] * alpha; acc[ai][bj][m][n] = o; sq += (o[0] * o[0] + o[1] * o[1]) + (o[2] * o[2] + o[3] * o[3]); }
                sq += __shfl_xor(sq, 16); sq += __shfl_xor(sq, 32);
                if (fq == 0) P[(ai * HALF + wr * 64 + m * 16 + fr) * 4 + wc] = sq; }
        }
        asm volatile("s_waitcnt lgkmcnt(0)" ::: "memory"); __builtin_amdgcn_s_barrier(); asm volatile("" ::: "memory");
        const int row = wid * 32 + (lane & 31);
        if (lane < 32) { const float t = (P[row * 4 + 0] + P[row * 4 + 1]) + (P[row * 4 + 2] + P[row * 4 + 3]);
            __hip_atomic_store(xs + (size_t)(u.pm * BM + row) * 8 + u.pn, t, __ATOMIC_RELAXED, __HIP_MEMORY_SCOPE_AGENT); }
        asm volatile("s_waitcnt vmcnt(0)" ::: "memory");
        if (lane == 0) __hip_atomic_fetch_add(cnt + 64 * u.pm, 1u, __ATOMIC_RELAXED, __HIP_MEMORY_SCOPE_AGENT);
        if (wid == 0) {
            for (unsigned sp = 0; sp < (1u << 22); ++sp) {
                if ((unsigned)__builtin_amdgcn_readfirstlane(__hip_atomic_load(cnt + 64 * u.pm, __ATOMIC_RELAXED, __HIP_MEMORY_SCOPE_AGENT)) >= 64u) break;
                __builtin_amdgcn_s_sleep(2);
            }
            __builtin_amdgcn_fence(__ATOMIC_ACQUIRE, "agent");
        }
        asm volatile("s_waitcnt vmcnt(0) lgkmcnt(0)" ::: "memory"); __builtin_amdgcn_s_barrier(); asm volatile("" ::: "memory");
        if (lane < 32) { const float* sl = xs + (size_t)(u.pm * BM + row) * 8; float t[8];
#pragma unroll
            for (int i = 0; i < 8; ++i) t[i] = __hip_atomic_load(sl + i, __ATOMIC_RELAXED, __HIP_MEMORY_SCOPE_AGENT);
            const float tot = ((t[0] + t[1]) + (t[2] + t[3])) + ((t[4] + t[5]) + (t[6] + t[7]));
            S[row] = __builtin_amdgcn_rsqf(tot * (1.0f / DMODEL) + RMS_EPS); }
        asm volatile("s_waitcnt lgkmcnt(0)" ::: "memory"); __builtin_amdgcn_s_barrier(); asm volatile("" ::: "memory");
        f32x4 gv[2][2];
#pragma unroll
        for (int bj = 0; bj < 2; ++bj)
#pragma unroll
            for (int n = 0; n < 2; ++n) gv[bj][n] = *(const f32x4*)(gain + col0 + bj * HALF + n * 16);
#pragma unroll
        for (int ai = 0; ai < 2; ++ai)
#pragma unroll
            for (int m = 0; m < 4; ++m) { const int rl = ai * HALF + wr * 64 + m * 16 + fr; const float rs = S[rl]; const size_t off = (size_t)(u.pm * BM + rl) * DMODEL + col0;
#pragma unroll
                for (int bj = 0; bj < 2; ++bj)
#pragma unroll
                    for (int n = 0; n < 2; ++n) *(f32x4*)(out + off + bj * HALF + n * 16) = acc[ai][bj][m][n] * rs * gv[bj][n]; }
    }
};

template <class Epi, class Sched, bool ALIGN_EPI = false, bool SP2 = false>
__device__ __forceinline__ void gemm_phase(PG8_LAS unsigned char* lds, const Gemm g, const Sched& S, const Epi& E) {
    int tid_o = threadIdx.x; asm volatile("" : "+v"(tid_o));
    const int tid = tid_o, wid = __builtin_amdgcn_readfirstlane(tid >> 6), lane = tid & 63, wr = wid >> 2, wc = wid & 3, fr = lane & 15, fq = lane >> 4;
    const int K = g.K, nt = K / BK;
    unsigned voffA[2], voffB[2];
#pragma unroll
    for (int i = 0; i < 2; ++i) { int R, C; stage_rc(tid * 16 + i * 8192, R, C); const int Rb = Epi::PERM ? ((R & ~31) + perm32(R & 31)) : R;
        voffA[i] = (unsigned)(R * K + C) * 2u; voffB[i] = (unsigned)(Rb * K + C) * 2u; }
    const size_t kstep = (size_t)(BK * 2);
    const size_t hstep = (size_t)HALF * K * 2;
    const size_t tstep = 2 * hstep;
    const unsigned ldsw = (unsigned)wid * 1024u;
    const int aoff = lds_byte(wr * 64 + fr, fq * 8), boff = lds_byte(wc * 32 + fr, fq * 8);
#define PG8_SA(b, h) (((b) * 2 + (h)) * HTB)
#define PG8_SB(b, h) ((4 + (b) * 2 + (h)) * HTB)
#define PG8_STAGE(bufoff, gbase, voff) do { _Pragma("unroll") for (int _i = 0; _i < 2; ++_i) \
        __builtin_amdgcn_global_load_lds((const unsigned*)((const char*)(gbase) + (voff)[_i]), (PG8_LAS unsigned*)(lds + (bufoff) + ldsw + _i * 8192), 16, 0, 0); } while (0)
#define PG8_LDA(dst, b, h) do { _Pragma("unroll") for (int m = 0; m < 4; ++m) _Pragma("unroll") for (int k = 0; k < 2; ++k) dst[m][k] = *(const PG8_LAS bf16x8*)(lds + PG8_SA(b, h) + aoff + m * 2048 + k * 1024); } while (0)
#define PG8_LDB(dst, b, h) do { _Pragma("unroll") for (int n = 0; n < 2; ++n) _Pragma("unroll") for (int k = 0; k < 2; ++k) dst[n][k] = *(const PG8_LAS bf16x8*)(lds + PG8_SB(b, h) + boff + n * 2048 + k * 1024); } while (0)
#define PG8_MMA(ai, bj, At, Bt) do { __builtin_amdgcn_s_setprio(1); _Pragma("unroll") for (int m = 0; m < 4; ++m) _Pragma("unroll") for (int n = 0; n < 2; ++n) _Pragma("unroll") for (int k = 0; k < 2; ++k) \
        acc[ai][bj][m][n] = __builtin_amdgcn_mfma_f32_16x16x32_bf16(Bt[n][k], At[m][k], acc[ai][bj][m][n], 0, 0, 0); __builtin_amdgcn_s_setprio(0); } while (0)
#define PG8_WAIT_V(n) asm volatile("s_waitcnt vmcnt(" #n ")" ::: "memory")
#define PG8_WAIT_L(n) asm volatile("s_waitcnt lgkmcnt(" #n ")" ::: "memory")
#define PG8_BAR __builtin_amdgcn_s_barrier()
#define PG8_SCHED __builtin_amdgcn_sched_barrier(0)
    Unit cur, nxt; int ui = 0;
    if (!S.next(0, cur)) return;
    f32x4 acc[2][2][4][2];
#pragma unroll
    for (int a = 0; a < 2; ++a)
#pragma unroll
        for (int b = 0; b < 2; ++b)
#pragma unroll
            for (int m = 0; m < 4; ++m)
#pragma unroll
                for (int n = 0; n < 2; ++n) acc[a][b][m][n] = (f32x4){0.f, 0.f, 0.f, 0.f};
    bf16x8 At[4][2], B0[2][2], B1[2][2];
    const char* cA = (const char*)g.A + (size_t)cur.pm * tstep; const char* cB = (const char*)g.Bt + (size_t)cur.pn * tstep;
    S.a_ready(cur);
    if constexpr (SP2) {
        PG8_STAGE(PG8_SB(0, 0), cB, voffB); PG8_STAGE(PG8_SB(0, 1), cB + hstep, voffB); PG8_STAGE(PG8_SA(0, 0), cA, voffA); PG8_STAGE(PG8_SA(0, 1), cA + hstep, voffA);
        if (wr == 1) PG8_BAR;
        PG8_WAIT_V(2); PG8_BAR;
        PG8_STAGE(PG8_SB(1, 0), cB + kstep, voffB); PG8_STAGE(PG8_SA(1, 0), cA + kstep, voffA); PG8_STAGE(PG8_SB(1, 1), cB + hstep + kstep, voffB);
        PG8_WAIT_V(6); PG8_BAR;
    } else {
        PG8_STAGE(PG8_SB(0, 0), cB, voffB); PG8_STAGE(PG8_SA(0, 0), cA, voffA); PG8_STAGE(PG8_SB(0, 1), cB + hstep, voffB); PG8_STAGE(PG8_SA(0, 1), cA + hstep, voffA);
        if (wr == 1) PG8_BAR;
        PG8_WAIT_V(4); PG8_BAR;
        PG8_STAGE(PG8_SB(1, 0), cB + kstep, voffB); PG8_STAGE(PG8_SA(1, 0), cA + kstep, voffA); PG8_STAGE(PG8_SB(1, 1), cB + hstep + kstep, voffB);
        PG8_WAIT_V(6); PG8_BAR;
    }
    for (;;) {
        const bool has_next = S.next(ui + 1, nxt);
        const char* nA = has_next ? (const char*)g.A + (size_t)nxt.pm * tstep : cA; const char* nB = has_next ? (const char*)g.Bt + (size_t)nxt.pn * tstep : cB;
        for (int t = 0; t < nt; t += 2) {
            const bool last = (t == nt - 2);
            const char* a1 = cA + (size_t)(t + 1) * kstep;
            const char* a2 = last ? nA : cA + (size_t)(t + 2) * kstep; const char* b2 = last ? nB : cB + (size_t)(t + 2) * kstep;
            const char* a3 = a2 + kstep; const char* b3 = b2 + kstep;
            if (last && has_next) S.a_ready(nxt);
            if constexpr (SP2) {
            PG8_LDB(B0, 0, 0); PG8_LDB(B1, 0, 1); PG8_SCHED; PG8_LDA(At, 0, 0); PG8_STAGE(PG8_SA(1, 1), a1 + hstep, voffA);
            PG8_WAIT_V(8); PG8_WAIT_L(0); PG8_BAR; PG8_MMA(0, 0, At, B0); PG8_MMA(0, 1, At, B1); PG8_BAR; PG8_SCHED;
            PG8_LDA(At, 0, 1); PG8_STAGE(PG8_SB(0, 0), b2, voffB); PG8_STAGE(PG8_SB(0, 1), b2 + hstep, voffB); PG8_STAGE(PG8_SA(0, 0), a2, voffA);
            PG8_WAIT_V(8); PG8_WAIT_L(0); PG8_BAR; PG8_MMA(1, 0, At, B0); PG8_MMA(1, 1, At, B1); PG8_BAR; PG8_SCHED;
            PG8_LDB(B0, 1, 0); PG8_LDB(B1, 1, 1); PG8_SCHED; PG8_LDA(At, 1, 0); PG8_STAGE(PG8_SA(0, 1), a2 + hstep, voffA);
            PG8_WAIT_V(8); PG8_WAIT_L(0); PG8_BAR; PG8_MMA(0, 0, At, B0); PG8_MMA(0, 1, At, B1); PG8_BAR; PG8_SCHED;
            PG8_LDA(At, 1, 1); PG8_STAGE(PG8_SB(1, 0), b3, voffB); PG8_STAGE(PG8_SB(1, 1), b3 + hstep, voffB); PG8_STAGE(PG8_SA(1, 0), a3, voffA);
            PG8_WAIT_V(8); PG8_WAIT_L(0); PG8_BAR; PG8_MMA(1, 0, At, B0); PG8_MMA(1, 1, At, B1); PG8_BAR; PG8_SCHED;
            } else {
            PG8_LDB(B0, 0, 0); PG8_SCHED; PG8_LDA(At, 0, 0); PG8_STAGE(PG8_SA(1, 1), a1 + hstep, voffA);
            PG8_WAIT_L(8); PG8_BAR; PG8_WAIT_L(0); PG8_MMA(0, 0, At, B0); PG8_BAR; PG8_SCHED;
            PG8_LDB(B1, 0, 1); PG8_STAGE(PG8_SB(0, 0), b2, voffB);
            PG8_BAR; PG8_WAIT_L(0); PG8_MMA(0, 1, At, B1); PG8_BAR;
            PG8_LDA(At, 0, 1); PG8_STAGE(PG8_SA(0, 0), a2, voffA);
            PG8_BAR; PG8_WAIT_L(0); PG8_MMA(1, 0, At, B0); PG8_BAR; PG8_SCHED;
            PG8_STAGE(PG8_SB(0, 1), b2 + hstep, voffB);
            PG8_WAIT_V(6); PG8_BAR; PG8_MMA(1, 1, At, B1); PG8_BAR;
            PG8_LDB(B0, 1, 0); PG8_SCHED; PG8_LDA(At, 1, 0); PG8_STAGE(PG8_SA(0, 1), a2 + hstep, voffA);
            PG8_WAIT_L(8); PG8_BAR; PG8_WAIT_L(0); PG8_MMA(0, 0, At, B0); PG8_BAR; PG8_SCHED;
            PG8_LDB(B1, 1, 1); PG8_STAGE(PG8_SB(1, 0), b3, voffB);
            PG8_BAR; PG8_WAIT_L(0); PG8_MMA(0, 1, At, B1); PG8_BAR;
            PG8_LDA(At, 1, 1); PG8_STAGE(PG8_SA(1, 0), a3, voffA);
            PG8_BAR; PG8_WAIT_L(0); PG8_MMA(1, 0, At, B0); PG8_BAR; PG8_SCHED;
            PG8_STAGE(PG8_SB(1, 1), b3 + hstep, voffB);
            PG8_WAIT_V(6); PG8_BAR; PG8_MMA(1, 1, At, B1); PG8_BAR;
            }
        }
        if constexpr (ALIGN_EPI) { if (wr == 0) PG8_BAR; }
        if constexpr (!Epi::AFTER_DRAIN) { E(acc, cur, wr, wc, fr, fq); S.done(cur); }
        if (!has_next) break;
#pragma unroll
        for (int a = 0; a < 2; ++a)
#pragma unroll
            for (int b = 0; b < 2; ++b)
#pragma unroll
                for (int m = 0; m < 4; ++m)
#pragma unroll
                    for (int n = 0; n < 2; ++n) acc[a][b][m][n] = (f32x4){0.f, 0.f, 0.f, 0.f};
        cur = nxt; cA = nA; cB = nB; ++ui;
        if constexpr (ALIGN_EPI) { if (wr == 1) PG8_BAR; }
    }
    PG8_WAIT_V(0);
    if constexpr (!ALIGN_EPI) { if (wr == 0) PG8_BAR; }
    PG8_BAR;
    if constexpr (Epi::AFTER_DRAIN) { E.fused(acc, cur, wr, wc, fr, fq, lds, wid, lane); S.done(cur); }
#undef PG8_SA
#undef PG8_SB
#undef PG8_STAGE
#undef PG8_LDA
#undef PG8_LDB
#undef PG8_MMA
#undef PG8_WAIT_V
#undef PG8_WAIT_L
#undef PG8_BAR
#undef PG8_SCHED
}
}

using namespace pg8;
#define LAS __attribute__((address_space(3)))
typedef float f32x16 __attribute__((ext_vector_type(16)));

constexpr int BATCH = 4, SEQ = 2048, M_TOK = BATCH * SEQ, DFF = 5632;
constexpr int PJ_LD = 8192;
constexpr int VT_LD = M_TOK;
constexpr float QA_SCALE = 0.125f * LOG2E, QB_SCALE = 0.08838834764831845f * LOG2E;

constexpr size_t MiB = 1u << 20;
constexpr size_t WS_SSQ0 = 0, WS_SSQ1 = 1 * MiB, WS_SSQ2 = 2 * MiB, WS_SSQ3 = 3 * MiB, WS_KMEAN = 4 * MiB, WS_XS = 4 * MiB + 512 * 1024, WS_BAR = 5 * MiB, BAR_BYTES = 32768;
constexpr size_t WS_WGU = 8 * MiB, WS_WDN = 52 * MiB, WS_WIN = 74 * MiB, WS_WV = 106 * MiB, WS_WPA = 114 * MiB, WS_WPB = 118 * MiB, WS_WO = 122 * MiB;
constexpr size_t WS_XB = 130 * MiB, WS_ACT = 162 * MiB, WS_OA = WS_ACT, WS_OB = WS_ACT + 16 * MiB, WS_PJ = 250 * MiB, WS_VT = 378 * MiB, WS_END = 410 * MiB;
constexpr size_t WS_WGU1 = WS_PJ, WS_WDN1 = WS_PJ + 44 * MiB;

constexpr int TAIL1_EXTRA = 7168;
constexpr int WGU2_EARLY = 3328;
constexpr int LDS_BYTES = 147456;

__device__ __forceinline__ float wave_sum(float v) {
#pragma unroll
    for (int o = 1; o < 64; o <<= 1) v += __shfl_xor(v, o);
    return v;
}
struct ConvDesc { const float* src; bf16_t* dst; const float* g; int Nsrc, K; };
#ifndef CONV_MODE
#define CONV_MODE 1
#endif
__device__ __forceinline__ ConvDesc conv_desc(const float* W, int K, int Nsrc, int c0, int nc, bf16_t* WT, int r0, const float* g, int mode, int item) {
    const int nblk = nc / 64;
    int kb, nb;
    if (CONV_MODE == 0) { kb = item / nblk; nb = item % nblk; }
    else { const int j = item & 7, t = item >> 3; nb = t % nblk; kb = (t / nblk) * 8 + j; }
    const int loc = 64 * nb;
    int dst = r0 + loc;
    if (mode == 1) { const int half = nc / 2; const int l2 = loc < half ? loc : loc - half; dst = r0 + 256 * (l2 / 128) + (l2 % 128) + (loc < half ? 0 : 128); }
    ConvDesc d; d.src = W + (size_t)(64 * kb) * Nsrc + c0 + loc; d.dst = WT + (size_t)dst * K + 64 * kb; d.g = g ? g + 64 * kb : nullptr; d.Nsrc = Nsrc; d.K = K;
    return d;
}
__device__ __forceinline__ void conv_load(const ConvDesc& d, f32x4 (&v)[16], int lane) {
    const int kq = lane >> 4, n4 = (lane & 15) * 4;
    const float* src = d.src + (size_t)(2 * kq) * d.Nsrc + n4;
#pragma unroll
    for (int i = 0; i < 8; ++i) { v[2 * i] = __builtin_nontemporal_load((const f32x4*)(src + (size_t)(8 * i) * d.Nsrc)); v[2 * i + 1] = __builtin_nontemporal_load((const f32x4*)(src + (size_t)(8 * i + 1) * d.Nsrc)); }
}
__device__ __forceinline__ void conv_scatter(const ConvDesc& d, f32x4 (&v)[16], LAS unsigned* scr, int lane) {
    const int kq = lane >> 4, n4 = (lane & 15) * 4;
    if (d.g) {
#pragma unroll
        for (int i = 0; i < 8; ++i) { const f32x2 gg = *(const f32x2*)(d.g + 8 * i + 2 * kq); v[2 * i] = v[2 * i] * gg.x; v[2 * i + 1] = v[2 * i + 1] * gg.y; } }
#pragma unroll
    for (int i = 0; i < 8; ++i)
#pragma unroll
        for (int j = 0; j < 4; ++j) scr[(n4 + j) * 33 + 4 * i + kq] = cvt_pk_bf16(v[2 * i][j], v[2 * i + 1][j]);
}
__device__ __forceinline__ void conv_store(const ConvDesc& d, const LAS unsigned* scr, int lane) {
    const int c = lane & 7, nl = lane >> 3;
#pragma unroll
    for (int jj = 0; jj < 8; ++jj) { const int n = nl + 8 * jj; const LAS unsigned* sp = scr + n * 33 + 4 * c;
        u32x4 o; o.x = sp[0]; o.y = sp[1]; o.z = sp[2]; o.w = sp[3];
        *(u32x4*)(d.dst + (size_t)n * d.K + 8 * c) = o; }
}
__device__ __forceinline__ void conv_pair(const ConvDesc& A, const ConvDesc& B, bool hasB, LAS unsigned* scr, int lane) {
    f32x4 va[16], vb[16];
    conv_load(A, va, lane);
    if (hasB) conv_load(B, vb, lane);
    conv_scatter(A, va, scr, lane);
    if (hasB) conv_scatter(B, vb, scr + 2112, lane);
    asm volatile("s_waitcnt lgkmcnt(0)" ::: "memory");
    conv_store(A, scr, lane);
    if (hasB) conv_store(B, scr + 2112, lane);
    asm volatile("s_waitcnt lgkmcnt(0)" ::: "memory");
}

constexpr int ATT_KPMAX = 272, ATT_VP = 144;
constexpr int ATT_LDS_KB = 64 * ATT_KPMAX, ATT_LDS_V0 = 2 * ATT_LDS_KB, ATT_LDS_VB = 128 * ATT_VP;
constexpr float ATT_NEG = -1e30f;
#define MFMA32(a, b, c) __builtin_amdgcn_mfma_f32_32x32x16_bf16((a), (b), (c), 0, 0, 0)

template <int DH, bool MOBA>
__device__ __forceinline__ void flash_pass(LAS unsigned char* lds, const bf16_t* qrow, const bf16_t* kbase, const bf16_t* vtbase, int q0, int qblk, float sl2, unsigned sel, f32x16 (&o)[4], int tid) {
    const int lane = tid & 63, r32 = lane & 31, hi = lane >> 5, wid = __builtin_amdgcn_readfirstlane(tid >> 6);
    constexpr int KP = DH * 2 + 16, KPIECES = DH / 8, KLD = (64 * KPIECES) / 512;
    bf16x8 qf[DH / 16];
#pragma unroll
    for (int d0 = 0; d0 < DH / 16; ++d0) qf[d0] = *(const bf16x8*)(qrow + d0 * 16 + hi * 8);
    const int qw0 = q0 + wid * 32, qpos = qw0 + r32;
    float m_run = 0.f, l_run = 0.f;
#pragma unroll
    for (int d = 0; d < 4; ++d)
#pragma unroll
        for (int r = 0; r < 16; ++r) o[d][r] = 0.f;
    const int NT = 4 * (qblk + 1);
    const int pg = r32 >> 3, phh = (r32 >> 2) & 1, pt = r32 & 3, prow = 16 * (pg >> 1) + 8 * phh + 4 * (pg & 1) + pt;
    const unsigned kfo = prow * KP + hi * 16, vfo = r32 * ATT_VP + hi * 16;
    u32x4 kreg[KLD], vreg[2];
#define TILE_OF(i) (MOBA ? ((((i) < 4) ? qblk : (((i) >> 2) - 1)) * 4 + ((i) & 3)) : (i))
#define LOADG(tile) do { const int kv0_ = (tile) * 64; \
        _Pragma("unroll") for (int j = 0; j < KLD; ++j) { const int p = tid + 512 * j, row = p / KPIECES, c = p % KPIECES; kreg[j] = *(const u32x4*)(kbase + (size_t)(kv0_ + row) * PJ_LD + c * 8); } \
        _Pragma("unroll") for (int j = 0; j < 2; ++j) { const int p = tid + 512 * j, d = p >> 3, c = p & 7; vreg[j] = *(const u32x4*)(vtbase + (size_t)d * VT_LD + kv0_ + c * 8); } } while (0)
#define STORE_LDS(buf) do { \
        _Pragma("unroll") for (int j = 0; j < KLD; ++j) { const int p = tid + 512 * j, row = p / KPIECES, c = p % KPIECES; *(LAS u32x4*)(lds + (buf) * ATT_LDS_KB + row * KP + c * 16) = kreg[j]; } \
        _Pragma("unroll") for (int j = 0; j < 2; ++j) { const int p = tid + 512 * j, d = p >> 3, c = p & 7; *(LAS u32x4*)(lds + ATT_LDS_V0 + (buf) * ATT_LDS_VB + d * ATT_VP + c * 16) = vreg[j]; } } while (0)
    LOADG(TILE_OF(0)); STORE_LDS(0); __syncthreads();
#pragma unroll 1
    for (int i = 0; i < NT; ++i) {
        const int tile = TILE_OF(i), kv0 = tile * 64, blk = tile >> 2, buf = i & 1;
        { const int in_ = (i + 1 < NT) ? i + 1 : i; LOADG(TILE_OF(in_)); }
        const bool diag = (blk == qblk);
        bool active = !(diag && kv0 > qw0 + 31);
        const bool mysel = MOBA ? (((sel >> blk) & 1u) != 0u) : true;
        if (MOBA && !diag) { if (!__any(mysel ? 1 : 0)) active = false; }
        if (active) {
            const LAS unsigned char* Kb = lds + buf * ATT_LDS_KB; const LAS unsigned char* Vb = lds + ATT_LDS_V0 + buf * ATT_LDS_VB;
            f32x16 s[2];
            const float fb = sl2 * (float)(kv0 + 8 * hi - qpos) - m_run;
            const int thr = qpos - kv0 - 8 * hi;
            const bool need = (diag && kv0 + 63 > qw0) || (MOBA && !diag && !__all(mysel ? 1 : 0));
            int thr_eff = diag ? thr : 4096;
            if (MOBA) thr_eff = (!diag && !mysel) ? -4096 : thr_eff;
            constexpr int NQK = DH / 16, PER = 16 / NQK;
            {
                const float fb0 = fb, fb1 = fb + sl2 * 16.0f;
#pragma unroll
                for (int r = 0; r < 16; ++r) s[0][r] = ((r >> 3) ? fb1 : fb0) + sl2 * (float)(r & 7);
            }
            const float fb2 = fb + sl2 * 32.0f, fb3 = fb + sl2 * 48.0f;
            __builtin_amdgcn_s_setprio(1);
#pragma unroll
            for (int g0 = 0; g0 < NQK; g0 += 4) {
                bf16x8 kf[4];
#pragma unroll
                for (int j4 = 0; j4 < 4; ++j4) kf[j4] = *(const LAS bf16x8*)(Kb + kfo + (g0 + j4) * 32);
#pragma unroll
                for (int j4 = 0; j4 < 4; ++j4) { const int d0 = g0 + j4;
                    s[0] = MFMA32(kf[j4], qf[d0], s[0]);
#pragma unroll
                    for (int j = 0; j < PER; ++j) { const int r = d0 * PER + j; s[1][r] = ((r >> 3) ? fb3 : fb2) + sl2 * (float)(r & 7); }
                }
                __builtin_amdgcn_sched_barrier(0);
            }
            __builtin_amdgcn_s_setprio(0);
            if (need) {
#pragma unroll
                for (int r = 0; r < 16; ++r) s[0][r] = (16 * (r >> 3) + (r & 7) > thr_eff) ? ATT_NEG : s[0][r];
            }
            float mx = fmaxf(fmaxf(s[0][0], s[0][1]), s[0][2]);
#pragma unroll
            for (int r = 3; r < 15; r += 2) mx = fmaxf(fmaxf(mx, s[0][r]), s[0][r + 1]);
            mx = fmaxf(mx, s[0][15]);
            __builtin_amdgcn_sched_barrier(0);
            __builtin_amdgcn_s_setprio(1);
#pragma unroll
            for (int g0 = 0; g0 < NQK; g0 += 4) {
                bf16x8 kf[4];
#pragma unroll
                for (int j4 = 0; j4 < 4; ++j4) kf[j4] = *(const LAS bf16x8*)(Kb + kfo + 32 * KP + (g0 + j4) * 32);
#pragma unroll
                for (int j4 = 0; j4 < 4; ++j4) { const int d0 = g0 + j4;
                    s[1] = MFMA32(kf[j4], qf[d0], s[1]);
#pragma unroll
                    for (int j = 0; j < PER; ++j) { const int r = d0 * PER + j; s[0][r] = __builtin_amdgcn_exp2f(s[0][r]); asm volatile("" : "+v"(s[0][r])); }
                    __builtin_amdgcn_sched_barrier(0);
                }
            }
            __builtin_amdgcn_s_setprio(0);
            if (need) {
#pragma unroll
                for (int r = 0; r < 16; ++r) s[1][r] = (32 + 16 * (r >> 3) + (r & 7) > thr_eff) ? ATT_NEG : s[1][r];
            }
            mx = fmaxf(fmaxf(mx, s[1][0]), s[1][1]);
#pragma unroll
            for (int r = 2; r < 16; r += 2) mx = fmaxf(fmaxf(mx, s[1][r]), s[1][r + 1]);
            mx = fmaxf(mx, __shfl_xor(mx, 32));
            if (__any(mx > 8.0f ? 1 : 0)) {
                const float dl = fmaxf(mx, 0.f), alpha = __builtin_amdgcn_exp2f(-dl);
                m_run += dl; l_run *= alpha;
#pragma unroll
                for (int d = 0; d < 4; ++d)
#pragma unroll
                    for (int r = 0; r < 16; ++r) o[d][r] *= alpha;
#pragma unroll
                for (int r = 0; r < 16; ++r) { s[0][r] *= alpha; s[1][r] -= dl; }
            }
#define PACK8(S, B) __builtin_bit_cast(bf16x8, (u32x4){cvt_pk_bf16(S[B], S[B + 1]), cvt_pk_bf16(S[B + 2], S[B + 3]), cvt_pk_bf16(S[B + 4], S[B + 5]), cvt_pk_bf16(S[B + 6], S[B + 7])})
            float lsum = 0.f;
#pragma unroll
            for (int r = 0; r < 16; ++r) lsum += s[0][r];
            bf16x8 pb[4];
            pb[0] = PACK8(s[0], 0); pb[1] = PACK8(s[0], 8);
            __builtin_amdgcn_sched_barrier(0);
            __builtin_amdgcn_s_setprio(1);
#pragma unroll
            for (int c = 0; c < 2; ++c) {
                bf16x8 vf[4];
#pragma unroll
                for (int d = 0; d < 4; ++d) vf[d] = *(const LAS bf16x8*)(Vb + vfo + d * 32 * ATT_VP + c * 32);
#pragma unroll
                for (int d = 0; d < 4; ++d) { o[d] = MFMA32(vf[d], pb[c], o[d]);
                    s[1][(c * 4 + d) * 2] = __builtin_amdgcn_exp2f(s[1][(c * 4 + d) * 2]); s[1][(c * 4 + d) * 2 + 1] = __builtin_amdgcn_exp2f(s[1][(c * 4 + d) * 2 + 1]);
                    __builtin_amdgcn_sched_barrier(0); }
            }
            pb[2] = PACK8(s[1], 0); pb[3] = PACK8(s[1], 8);
            __builtin_amdgcn_sched_barrier(0);
#pragma unroll
            for (int c = 2; c < 4; ++c) {
                bf16x8 vf[4];
#pragma unroll
                for (int d = 0; d < 4; ++d) vf[d] = *(const LAS bf16x8*)(Vb + vfo + d * 32 * ATT_VP + c * 32);
#pragma unroll
                for (int d = 0; d < 4; ++d) { o[d] = MFMA32(vf[d], pb[c], o[d]);
                    lsum += s[1][((c - 2) * 4 + d) * 2] + s[1][((c - 2) * 4 + d) * 2 + 1];
                    __builtin_amdgcn_sched_barrier(0); }
            }
            __builtin_amdgcn_s_setprio(0);
            l_run += lsum;
#undef PACK8
        }
        STORE_LDS((i + 1) & 1);
        __syncthreads();
    }
#undef TILE_OF
#undef LOADG
#undef STORE_LDS
    const float lt = l_run + __shfl_xor(l_run, 32), inv = 1.0f / lt;
#pragma unroll
    for (int d = 0; d < 4; ++d)
#pragma unroll
        for (int r = 0; r < 16; ++r) o[d][r] *= inv;
}

#define XB_TMO      128
#define XB_XCNT(j)  (256  + 64 * (j))
#define XB_XSUB(j)  (1280 + 64 * (j))
#define XB_XGEN(j)  (2304 + 64 * (j))
#define XB_TOP      3328
#define XB_TOPGEN   3392
#define XCD_BAR_WORDS 3456
#define XB_SPIN_CAP (1u << 18)

__device__ __forceinline__ unsigned xb_ld(unsigned* p)              { return __hip_atomic_load(p, __ATOMIC_RELAXED, __HIP_MEMORY_SCOPE_AGENT); }
__device__ __forceinline__ unsigned xb_add(unsigned* p, unsigned v) { return __hip_atomic_fetch_add(p, v, __ATOMIC_RELAXED, __HIP_MEMORY_SCOPE_AGENT); }
__device__ __forceinline__ unsigned xb_xcc_id() { return (unsigned)__builtin_amdgcn_s_getreg((3 << 11) | 20) & 0xFu; }
#define XB_SPIN(cond, bar) do { unsigned _sp = 0; while (cond) { __builtin_amdgcn_s_sleep(1); \
    if ((++_sp & 255u) == 0u) { if (xb_ld(&(bar)[XB_TMO])) break; if (_sp > XB_SPIN_CAP) { atomicAdd(&(bar)[XB_TMO], 1u); break; } } } } while (0)

struct XcdBarrier {
    unsigned* bar; unsigned x;
    volatile LAS unsigned* st;
};

__device__ __forceinline__ XcdBarrier xcd_barrier_post(unsigned* bar, volatile LAS unsigned* st) {
    XcdBarrier b; b.bar = bar; b.x = xb_xcc_id(); b.st = st;
    if (threadIdx.x == 0) (void)xb_add(&bar[XB_XCNT(b.x)], 1u);
    return b;
}
__device__ __forceinline__ void xcd_barrier_complete(unsigned* bar, unsigned x, unsigned& nloc, unsigned& nx) {
    const unsigned G = gridDim.x * gridDim.y * gridDim.z;
    unsigned sum, cnt, mine, sp = 0u;
    for (;;) {
        sum = 0u; cnt = 0u; mine = 0u;
#pragma unroll
        for (unsigned j = 0; j < 16; ++j) { const unsigned c = xb_ld(&bar[XB_XCNT(j)]); sum += c; cnt += (c > 0u) ? 1u : 0u; mine = (j == x) ? c : mine; }
        if (sum == G) break;
        __builtin_amdgcn_s_sleep(1);
        if ((++sp & 255u) == 0u) { if (xb_ld(&bar[XB_TMO])) break; if (sp > XB_SPIN_CAP) { atomicAdd(&bar[XB_TMO], 1u); break; } }
    }
    nloc = mine > 0u ? mine : 1u; nx = cnt > 0u ? cnt : 1u;
}

__device__ __forceinline__ void xcd_barrier(const XcdBarrier& b) {
    asm volatile("s_waitcnt vmcnt(0)" ::: "memory");
    __syncthreads();
    if (threadIdx.x == 0) {
        unsigned* bar = b.bar;
        __builtin_amdgcn_s_waitcnt(0);
        unsigned nloc = b.st[0], nx = b.st[1];
        if (nloc == 0u) { xcd_barrier_complete(bar, b.x, nloc, nx); b.st[0] = nloc; b.st[1] = nx; }
        const unsigned old = xb_add(&bar[XB_XSUB(b.x)], 1u);
        const unsigned gen = old / nloc;
        if (old + 1u == (gen + 1u) * nloc) {
            __builtin_amdgcn_fence(__ATOMIC_RELEASE, "agent");
            asm volatile("s_waitcnt vmcnt(0)" ::: "memory");
            const unsigned og = xb_add(&bar[XB_TOP], 1u);
            const unsigned tg = og / nx;
            if (og + 1u == (tg + 1u) * nx) xb_add(&bar[XB_TOPGEN], 1u);
            else XB_SPIN(xb_ld(&bar[XB_TOPGEN]) == tg, bar);
            __builtin_amdgcn_fence(__ATOMIC_ACQUIRE, "agent");
            xb_add(&bar[XB_XGEN(b.x)], 1u);
            asm volatile("s_waitcnt vmcnt(0)" ::: "memory");
        } else {
            XB_SPIN(xb_ld(&bar[XB_XGEN(b.x)]) == gen, bar);
            __builtin_amdgcn_fence(__ATOMIC_ACQUIRE, "agent");
            asm volatile("s_waitcnt vmcnt(0)" ::: "memory");
        }
    }
    __syncthreads();
}

#ifndef PHASES
#define PHASES 0xFFFF
#endif
#ifndef DUP_MASK
#define DUP_MASK 0
#endif
#define REP(bit) _Pragma("unroll 1") for (int rep_ = 0; rep_ < 1 + ((DUP_MASK >> (bit)) & 1); ++rep_)
struct Args { const float* in[18]; float* out; unsigned char* ws; };

__global__ void __launch_bounds__(512, 2) mega_fwd(Args a) {
    extern __shared__ __attribute__((aligned(16))) unsigned char lds_raw[];
    LAS unsigned char* lds = (LAS unsigned char*)lds_raw;
    cg::grid_group grid = cg::this_grid();
    const int G = gridDim.x, NGW = G * 8;
    volatile LAS unsigned* bar_st = (volatile LAS unsigned*)(lds + LDS_BYTES - 64);
    if (threadIdx.x < 2) bar_st[threadIdx.x] = 0u;
    __syncthreads();
    const XcdBarrier xbar = xcd_barrier_post((unsigned*)(a.ws + WS_BAR), bar_st);
#define SEAM() xcd_barrier(xbar)
    if (a.out == nullptr) grid.sync();
#define PHASE_IDS() int tid_o = threadIdx.x; asm volatile("" : "+v"(tid_o)); const int tid = tid_o, lane = tid & 63, wave = __builtin_amdgcn_readfirstlane(tid >> 6), gw = blockIdx.x * 8 + wave; \
    LAS unsigned* scr = (LAS unsigned*)(lds + wave * 16896); (void)tid; (void)lane; (void)gw; (void)scr;
    unsigned char* ws = a.ws;
    float* SSQ0 = (float*)(ws + WS_SSQ0); float* SSQ1 = (float*)(ws + WS_SSQ1); float* SSQ2 = (float*)(ws + WS_SSQ2); float* SSQ3 = (float*)(ws + WS_SSQ3);
    float* KMEAN = (float*)(ws + WS_KMEAN);
    bf16_t* WGU = (bf16_t*)(ws + WS_WGU); bf16_t* WDN = (bf16_t*)(ws + WS_WDN); bf16_t* WGU1 = (bf16_t*)(ws + WS_WGU1); bf16_t* WDN1 = (bf16_t*)(ws + WS_WDN1); bf16_t* WIN = (bf16_t*)(ws + WS_WIN); bf16_t* WV = (bf16_t*)(ws + WS_WV);
    bf16_t* WPA = (bf16_t*)(ws + WS_WPA); bf16_t* WPB = (bf16_t*)(ws + WS_WPB); bf16_t* WO = (bf16_t*)(ws + WS_WO);
    bf16_t* XB = (bf16_t*)(ws + WS_XB); bf16_t* ACT = (bf16_t*)(ws + WS_ACT); bf16_t* OA = (bf16_t*)(ws + WS_OA); bf16_t* OB = (bf16_t*)(ws + WS_OB);
    bf16_t* PJ = (bf16_t*)(ws + WS_PJ); bf16_t* VT = (bf16_t*)(ws + WS_VT); bf16_t* MG = VT;
    float* STASH = (float*)(ws + WS_ACT + 32 * MiB);
    float* XR = a.out;

    if (PHASES & (1 << 0)) REP(0)
    {
        PHASE_IDS();
        constexpr int NI = 5632 + 1024 + 1024 + 2048 + 512 + 512 + 512 + 512 + 1024 + WGU2_EARLY;
#define P0_DESC(it_, D) do { int r = (it_); const float* W; int K, Nsrc, c0, nc, r0 = 0, mode = 0; bf16_t* WT; const float* g = nullptr; \
            if (r < 5632) { W = a.in[2]; K = 2048; Nsrc = 11264; c0 = 0; nc = 11264; WT = WGU1; g = a.in[1]; mode = 1; } \
            else if ((r -= 5632) < 1024) { W = a.in[5]; K = 2048; Nsrc = 10240; c0 = 0; nc = 2048; WT = WIN; r0 = 0; g = a.in[4]; } \
            else if ((r -= 1024) < 1024) { W = a.in[5]; K = 2048; Nsrc = 10240; c0 = 3072; nc = 2048; WT = WIN; r0 = 2048; g = a.in[4]; } \
            else if ((r -= 1024) < 2048) { W = a.in[5]; K = 2048; Nsrc = 10240; c0 = 6144; nc = 4096; WT = WIN; r0 = 4096; g = a.in[4]; } \
            else if ((r -= 2048) < 512) { W = a.in[5]; K = 2048; Nsrc = 10240; c0 = 2048; nc = 1024; WT = WV; r0 = 0; g = a.in[4]; } \
            else if ((r -= 512) < 512) { W = a.in[5]; K = 2048; Nsrc = 10240; c0 = 5120; nc = 1024; WT = WV; r0 = 1024; g = a.in[4]; } \
            else if ((r -= 512) < 512) { W = a.in[11]; K = 1024; Nsrc = 2048; c0 = 0; nc = 2048; WT = WPA; } \
            else if ((r -= 512) < 512) { W = a.in[12]; K = 1024; Nsrc = 2048; c0 = 0; nc = 2048; WT = WPB; } \
            else if ((r -= 512) < 1024) { W = a.in[13]; K = 2048; Nsrc = 2048; c0 = 0; nc = 2048; WT = WO; } \
            else { r -= 1024; W = a.in[15]; K = 2048; Nsrc = 11264; c0 = 0; nc = 11264; WT = WGU; g = a.in[14]; mode = 1; } \
            D = conv_desc(W, K, Nsrc, c0, nc, WT, r0, g, mode, r); } while (0)
        const bool skip_late = (G == 256);
        for (int it = gw; it < NI - (skip_late ? 7168 : 0); it += NGW) {
            ConvDesc A; P0_DESC(!skip_late ? it : (it < 5632 ? it : it + 7168), A);
            conv_pair(A, A, false, scr, lane);
        }
#undef P0_DESC
        const float* x = a.in[0];
        for (int row = gw; row < M_TOK; row += NGW) {
            const f32x4* xr = (const f32x4*)(x + (size_t)row * DMODEL) + lane; float s = 0.f;
            u32x2* ob = (u32x2*)(XB + (size_t)row * DMODEL) + lane;
            f32x4 xv[8];
#pragma unroll
            for (int j = 0; j < 8; ++j) xv[j] = __builtin_nontemporal_load(xr + 64 * j);
#pragma unroll
            for (int j = 0; j < 8; ++j) { const f32x4 v = xv[j]; s += (v[0] * v[0] + v[1] * v[1]) + (v[2] * v[2] + v[3] * v[3]); u32x2 w; w.x = cvt_pk_bf16(v[0], v[1]); w.y = cvt_pk_bf16(v[2], v[3]); ob[64 * j] = w; }
            s = wave_sum(s);
            if (lane < 32) SSQ0[(size_t)row * 32 + lane] = (lane == 0) ? s : 0.f;
        }
    }
    SEAM();

    if (PHASES & (1 << 1)) REP(1)
    {
    { Gemm g{XB, WGU1, M_TOK, 2 * DFF, DMODEL}; StaticOrder S; S.init(M_TOK, 2 * DFF, G, (int)blockIdx.x); EpiSwiglu E{ACT, DFF, SSQ0};
      gemm_phase<EpiSwiglu, StaticOrder, true, true>(lds, g, S, E); }
    {
        PHASE_IDS();
        const int nwg = (M_TOK / 256) * (2 * DFF / 256), rounds = (nwg + G - 1) / G, rem = nwg - (rounds - 1) * G;
        int first = gw, stride = NGW;
        if (rem < G) { first = ((int)blockIdx.x - rem) * 8 + wave; stride = (G - rem) * 8; if ((int)blockIdx.x < rem) first = 1 << 30; }
#define T1_DESC(it_, D) do { if ((it_) < 2816) D = conv_desc(a.in[3], 5632, 2048, 0, 2048, WDN1, 0, nullptr, 0, (it_)); \
            else if (G != 256) D = conv_desc(a.in[15], 2048, 11264, 0, 11264, WGU, 0, a.in[14], 1, (it_) - 2816 + WGU2_EARLY); \
            else if ((it_) < 2816 + 512) D = conv_desc(a.in[11], 1024, 2048, 0, 2048, WPA, 0, nullptr, 0, (it_) - 2816); \
            else if ((it_) < 2816 + 1024) D = conv_desc(a.in[12], 1024, 2048, 0, 2048, WPB, 0, nullptr, 0, (it_) - 2816 - 512); \
            else if ((it_) < 2816 + 2048) D = conv_desc(a.in[13], 2048, 2048, 0, 2048, WO, 0, nullptr, 0, (it_) - 2816 - 1024); \
            else if ((it_) < 2816 + 4096) D = conv_desc(a.in[5], 2048, 10240, 6144, 4096, WIN, 4096, a.in[4], 0, (it_) - 2816 - 2048); \
            else if ((it_) < 2816 + 5120) D = conv_desc(a.in[5], 2048, 10240, 0, 2048, WIN, 0, a.in[4], 0, (it_) - 2816 - 4096); \
            else if ((it_) < 2816 + 6144) D = conv_desc(a.in[5], 2048, 10240, 3072, 2048, WIN, 2048, a.in[4], 0, (it_) - 2816 - 5120); \
            else if ((it_) < 2816 + 6656) D = conv_desc(a.in[5], 2048, 10240, 2048, 1024, WV, 0, a.in[4], 0, (it_) - 2816 - 6144); \
            else D = conv_desc(a.in[5], 2048, 10240, 5120, 1024, WV, 1024, a.in[4], 0, (it_) - 2816 - 6656); } while (0)
        for (int it = first; it < (G == 256 ? 2816 + TAIL1_EXTRA : 2816 + 5632 - WGU2_EARLY); it += stride) {
            ConvDesc A; T1_DESC(it, A);
            conv_pair(A, A, false, scr, lane);
        }
#undef T1_DESC
        __syncthreads();
    }
    }
    SEAM();
    if ((DUP_MASK >> 17) & 1) { _Pragma("unroll 1") for (int q = 0; q < 20; ++q) SEAM(); }
    if (PHASES & (1 << 2)) REP(2)
    { Gemm g{ACT, WDN1, M_TOK, DMODEL, DFF}; StaticOrder S; S.init(M_TOK, DMODEL, G, (int)blockIdx.x); EpiRes E{a.in[0], XR, XB, SSQ1, 0.5f};
      gemm_phase<EpiRes, StaticOrder, true, true>(lds, g, S, E); }
    SEAM();
    if (PHASES & (1 << 3)) REP(3)
    {
    { Gemm g{XB, WIN, M_TOK, PJ_LD, DMODEL}; StaticOrder S; S.init(M_TOK, PJ_LD, G, (int)blockIdx.x); EpiProj E{PJ, PJ_LD, SSQ1, QA_SCALE, QB_SCALE, KMEAN};
      gemm_phase<EpiProj, StaticOrder, true, true>(lds, g, S, E); }
    { Gemm g{WV, XB, 2048, M_TOK, DMODEL}; StaticOrder S; S.init(2048, M_TOK, G, (int)blockIdx.x); EpiVt E{VT, VT_LD, SSQ1};
      gemm_phase<EpiVt, StaticOrder, true, true>(lds, g, S, E); }
    }
    SEAM();
    if (PHASES & (1 << 5)) REP(5)
    {
        float lam;
        { int l_o = threadIdx.x; asm volatile("" : "+v"(l_o)); const int lane = l_o & 63; const float p1 = wave_sum(a.in[6][lane] * a.in[7][lane]), p2 = wave_sum(a.in[8][lane] * a.in[9][lane]); lam = __uint_as_float(__builtin_amdgcn_readfirstlane(__float_as_uint(expf(p1) - expf(p2) + 0.2f))); }
        unsigned* cnt_u = (unsigned*)(a.ws + WS_BAR) + 3600; unsigned* cnt_c = (unsigned*)(a.ws + WS_BAR) + 3968;
        volatile LAS unsigned* wq = (volatile LAS unsigned*)(lds + LDS_BYTES - 128);
        const int xq = (int)(blockIdx.x & 7);
#ifndef ATT_DYNAMIC
#define ATT_DYNAMIC 0
#endif
#pragma unroll 1
        for (int ustat = blockIdx.x;; ustat += G) {
            int ucode, useq;
            if (ATT_DYNAMIC) {
                __syncthreads();
                if (threadIdx.x == 0) wq[0] = __hip_atomic_fetch_add(cnt_u + 16 * xq, 1u, __ATOMIC_RELAXED, __HIP_MEMORY_SCOPE_AGENT);
                __syncthreads();
                const int useq8 = __builtin_amdgcn_readfirstlane((int)wq[0]);
                if (useq8 >= 64) break;
                ucode = (int)((0x809A1B2CD3E4F567ull >> (4 * (useq8 >> 2))) & 15ull);
                useq = (useq8 & 3) * 8 + xq;
            } else {
                if (G == 256) {
                    const int k = (int)blockIdx.x >> 5, ui = (ustat - (int)blockIdx.x) >> 8;
                    const int nu = (k == 0) ? 1 : (k == 7 ? 3 : 2);
                    if (ui >= nu * (1 + ((DUP_MASK >> 16) & 1))) break;
                    const unsigned codes = (k == 0) ? 0x007u : (k == 1) ? 0x006u : (k == 2) ? 0x015u : (k == 3) ? 0x024u : (k == 4) ? 0x0D3u : (k == 5) ? 0x0BFu : (k == 6) ? 0x0CEu : 0x89Au;
                    ucode = (int)((codes >> (4 * (ui % nu))) & 15u); useq = (int)blockIdx.x & 31;
                } else {
                if (ustat >= 512 * (1 + ((DUP_MASK >> 16) & 1))) break;
                const int us = ustat & 511;
                useq = us & 31; ucode = us < 256 ? (us >> 5) : (8 | (7 - ((us - 256) >> 5)));
                }
            }
            int tid_o = threadIdx.x; asm volatile("" : "+v"(tid_o));
            const int tid = tid_o, lane = tid & 63, r32 = lane & 31, hi = lane >> 5, wave = __builtin_amdgcn_readfirstlane(tid >> 6);
#ifndef TEST_ATT
#define TEST_ATT 3
#endif
            if (ucode < 8) { if (TEST_ATT & 1) {
                const int qblk = ucode & 7, bh = useq & 31, b = bh >> 3, h = bh & 7, q0 = qblk * 256;
                const float sl2 = exp2f(-(float)(h + 1)) * LOG2E;
                const size_t row = (size_t)b * SEQ + q0 + wave * 32 + r32;
                f32x16 o[4];
                f32x4* stash = (f32x4*)(STASH + ((size_t)blockIdx.x * 512 + tid) * 64);
#pragma unroll 1
                for (int mp = 0; mp < 2; ++mp) {
                    flash_pass<64, false>(lds, PJ + row * PJ_LD + h * 128 + mp * 64, PJ + (size_t)b * SEQ * PJ_LD + 1024 + h * 128 + mp * 64, VT + (size_t)(h * 128) * VT_LD + (size_t)b * SEQ, q0, qblk, sl2, 0u, o, tid);
                    if (mp == 0) {
#pragma unroll
                        for (int d = 0; d < 4; ++d)
#pragma unroll
                            for (int g4 = 0; g4 < 4; ++g4) stash[d * 4 + g4] = (f32x4){o[d][4 * g4], o[d][4 * g4 + 1], o[d][4 * g4 + 2], o[d][4 * g4 + 3]}; }
                }
                float ss = 0.f;
#pragma unroll
                for (int d = 0; d < 4; ++d) {
#pragma unroll
                    for (int g4 = 0; g4 < 4; ++g4) { const f32x4 s0 = stash[d * 4 + g4];
#pragma unroll
                        for (int j = 0; j < 4; ++j) { const float v = s0[j] - lam * o[d][4 * g4 + j]; o[d][4 * g4 + j] = v; ss += v * v; } }
                    __builtin_amdgcn_sched_barrier(0); }
                ss += __shfl_xor(ss, 32);
                const float rinv = rsqrtf(ss * (1.0f / 128.0f) + RMS_EPS) * 0.8f;
                bf16_t* op = OA + row * 1024 + h * 128;
#pragma unroll
                for (int d = 0; d < 4; ++d)
#pragma unroll
                    for (int g4 = 0; g4 < 4; ++g4) { const int dd = 32 * d + 8 * g4 + 4 * hi; const f32x4 gs = *(const f32x4*)(a.in[10] + dd);
                        u32x2 w; w.x = cvt_pk_bf16(o[d][4 * g4 + 0] * rinv * gs[0], o[d][4 * g4 + 1] * rinv * gs[1]); w.y = cvt_pk_bf16(o[d][4 * g4 + 2] * rinv * gs[2], o[d][4 * g4 + 3] * rinv * gs[3]);
                        *(u32x2*)(op + dd) = w; }
            } } else if (TEST_ATT & 2) {
                const int qblk = ucode & 7, bh = useq & 31, b = bh >> 3, h = bh & 7, q0 = qblk * 256;
                const float sl2 = exp2f(-(float)(h + 1)) * LOG2E;
                const size_t row = (size_t)b * SEQ + q0 + wave * 32 + r32;
                const bf16_t* qp = PJ + row * PJ_LD + 2048 + h * 128;
                unsigned sel = 0u;
                if (qblk <= 3) sel = (1u << qblk) - 1u;
                else {
                    float qv[64];
#pragma unroll
                    for (int i = 0; i < 8; ++i) { const u32x4 w = *(const u32x4*)(qp + 64 * hi + 8 * i);
                        qv[8 * i + 0] = bf_lo(w.x); qv[8 * i + 1] = bf_hi(w.x); qv[8 * i + 2] = bf_lo(w.y); qv[8 * i + 3] = bf_hi(w.y); qv[8 * i + 4] = bf_lo(w.z); qv[8 * i + 5] = bf_hi(w.z); qv[8 * i + 6] = bf_lo(w.w); qv[8 * i + 7] = bf_hi(w.w); }
                    LAS float* kml = (LAS float*)(lds + 73728);
                    for (int idx = tid; idx < qblk * 128; idx += 512) { const float* kp = KMEAN + (size_t)(b * 8 + (idx >> 7)) * 2048 + h * 128 + (idx & 127); kml[idx] = kp[0] + kp[1024]; }
                    __syncthreads();
                    float gs[7];
#pragma unroll
                    for (int j = 0; j < 7; ++j) { gs[j] = 0.f;
                        if (j < qblk) { const LAS f32x4* km = (const LAS f32x4*)(kml + j * 128 + 64 * hi); float acc = 0.f;
#pragma unroll
                            for (int i = 0; i < 16; ++i) { const f32x4 k4 = km[i]; acc += qv[4 * i] * k4[0] + qv[4 * i + 1] * k4[1] + qv[4 * i + 2] * k4[2] + qv[4 * i + 3] * k4[3]; }
                            gs[j] = acc + __shfl_xor(acc, 32); }
                        __builtin_amdgcn_sched_barrier(0); }
#pragma unroll
                    for (int t = 0; t < 3; ++t) { float best = -INFINITY; int bi = 0;
#pragma unroll
                        for (int j = 0; j < 7; ++j) { if (j < qblk && !((sel >> j) & 1u) && gs[j] > best) { best = gs[j]; bi = j; } }
                        sel |= 1u << bi; }
                }
                f32x16 o[4];
                flash_pass<128, true>(lds, qp, PJ + (size_t)b * SEQ * PJ_LD + 3072 + h * 128, VT + (size_t)(1024 + h * 128) * VT_LD + (size_t)b * SEQ, q0, qblk, sl2, sel, o, tid);
                bf16_t* op = OB + row * 1024 + h * 128;
#pragma unroll
                for (int d = 0; d < 4; ++d)
#pragma unroll
                    for (int g4 = 0; g4 < 4; ++g4) { const int dd = 32 * d + 8 * g4 + 4 * hi;
                        u32x2 w; w.x = cvt_pk_bf16(o[d][4 * g4 + 0], o[d][4 * g4 + 1]); w.y = cvt_pk_bf16(o[d][4 * g4 + 2], o[d][4 * g4 + 3]);
                        *(u32x2*)(op + dd) = w; }
            }
        }
        if (G == 256 && ((int)blockIdx.x >> 5) == 7) {
            PHASE_IDS();
            __syncthreads();
            for (int it = WGU2_EARLY + ((int)blockIdx.x & 31) * 8 + wave; it < 5632; it += 256) {
                const ConvDesc A = conv_desc(a.in[15], 2048, 11264, 0, 11264, WGU, 0, a.in[14], 1, it);
                conv_pair(A, A, false, scr, lane);
            }
            __syncthreads();
        }
        if (ATT_DYNAMIC) {
            PHASE_IDS();
#pragma unroll 1
            for (;;) {
                unsigned itv = 0u; if (lane == 0) itv = __hip_atomic_fetch_add(cnt_c, 1u, __ATOMIC_RELAXED, __HIP_MEMORY_SCOPE_AGENT);
                const int it = __builtin_amdgcn_readfirstlane((int)itv);
                if (it >= 5632) break;
                const ConvDesc A = conv_desc(a.in[15], 2048, 11264, 0, 11264, WGU, 0, a.in[14], 1, it);
                conv_pair(A, A, false, scr, lane);
            }
        }
    }
    SEAM();
    if (PHASES & (1 << 6)) REP(6)
    {
    { static_assert(WS_OB - WS_OA == (size_t)M_TOK * 1024 * 2 && WS_WPB - WS_WPA == (size_t)DMODEL * 1024 * 2, "stacked operands of the paired gate GEMMs must be contiguous");
      Gemm g{OA, WPA, 2 * M_TOK, 2 * DMODEL, 1024}; PairOrder S; S.s.init(M_TOK, DMODEL, G, (int)blockIdx.x); EpiGatePair E{MG, PJ, PJ_LD};
      gemm_phase<EpiGatePair, PairOrder, true, true>(lds, g, S, E); }
    }
    SEAM();
    if (PHASES & (1 << 7)) REP(7)
    { Gemm g{MG, WO, M_TOK, DMODEL, DMODEL}; StaticOrder S; S.init(M_TOK, DMODEL, G, (int)blockIdx.x); EpiRes E{XR, XR, XB, SSQ2, 1.0f};
      gemm_phase<EpiRes, StaticOrder, true, true>(lds, g, S, E); }
    SEAM();
    if (PHASES & (1 << 8)) REP(8)
    {
    { Gemm g{XB, WGU, M_TOK, 2 * DFF, DMODEL}; StaticOrder S; S.init(M_TOK, 2 * DFF, G, (int)blockIdx.x); EpiSwiglu E{ACT, DFF, SSQ2};
      gemm_phase<EpiSwiglu, StaticOrder, true, true>(lds, g, S, E); }
    {
        PHASE_IDS();
        const int nwg = (M_TOK / 256) * (2 * DFF / 256), rounds = (nwg + G - 1) / G, rem = nwg - (rounds - 1) * G;
        int first = gw, stride = NGW;
        if (rem < G) { first = ((int)blockIdx.x - rem) * 8 + wave; stride = (G - rem) * 8; if ((int)blockIdx.x < rem) first = 1 << 30; }
        for (int it = first; it < 2816; it += stride) {
            const ConvDesc A = conv_desc(a.in[16], 5632, 2048, 0, 2048, WDN, 0, nullptr, 0, it);
            conv_pair(A, A, false, scr, lane);
        }
        __syncthreads();
    }
    }
    SEAM();
    if (G == 256) {
        Gemm g{ACT, WDN, M_TOK, DMODEL, DFF}; StaticOrder S; S.init(M_TOK, DMODEL, G, (int)blockIdx.x);
        EpiResNorm E{XR, XR, a.in[17], 0.5f, (float*)(ws + WS_XS), (unsigned*)(ws + WS_BAR) + 4096};
        gemm_phase<EpiResNorm, StaticOrder, false, true>(lds, g, S, E);
    } else {
    { Gemm g{ACT, WDN, M_TOK, DMODEL, DFF}; StaticOrder S; S.init(M_TOK, DMODEL, G, (int)blockIdx.x); EpiRes E{XR, XR, nullptr, SSQ3, 0.5f};
      gemm_phase<EpiRes, StaticOrder, true, true>(lds, g, S, E); }
    SEAM();
    {
        PHASE_IDS();
        const f32x4* gf = (const f32x4*)a.in[17] + lane;
        for (int row = gw; row < M_TOK; row += NGW) {
            const float rs = row_rstd(SSQ3, row);
            f32x4* xr = (f32x4*)(XR + (size_t)row * DMODEL) + lane;
            f32x4 xv[8];
#pragma unroll
            for (int j = 0; j < 8; ++j) xv[j] = xr[64 * j];
#pragma unroll
            for (int j = 0; j < 8; ++j) xr[64 * j] = xv[j] * rs * gf[64 * j];
        }
    }
    }
}

extern "C" void kernel_launch(void* const* d_in, const int* in_sizes, int n_in, void* d_out, int out_size, void* d_ws, size_t ws_size, hipStream_t stream) {
    static int grid_blocks = 0;
    if (grid_blocks == 0) {
        if (n_in != 18 || out_size != M_TOK * DMODEL || ws_size < WS_END) { fprintf(stderr, "kernel_launch: unexpected shapes (n_in %d out %d ws %zu)\n", n_in, out_size, ws_size); grid_blocks = -1; return; }
        int dev = 0, cus = 0, per_cu = 0;
        (void)hipGetDevice(&dev);
        (void)hipDeviceGetAttribute(&cus, hipDeviceAttributeMultiprocessorCount, dev);
        (void)hipFuncSetAttribute((const void*)mega_fwd, hipFuncAttributeMaxDynamicSharedMemorySize, LDS_BYTES);
        (void)hipOccupancyMaxActiveBlocksPerMultiprocessor(&per_cu, (const void*)mega_fwd, 512, LDS_BYTES);
        if (per_cu < 1) { fprintf(stderr, "kernel_launch: occupancy query says %d blocks per CU\n", per_cu); per_cu = 1; }
        grid_blocks = cus < 256 ? cus : 256;
        (void)hipGetLastError();
    }
    if (grid_blocks < 0) return;
    (void)hipMemsetAsync((unsigned char*)d_ws + WS_BAR, 0, BAR_BYTES, stream);
    Args a{};
    for (int i = 0; i < 18; ++i) a.in[i] = (const float*)d_in[i];
    a.out = (float*)d_out; a.ws = (unsigned char*)d_ws;
    void* args[] = {&a};
    hipError_t e = hipLaunchCooperativeKernel((const void*)mega_fwd, dim3(grid_blocks), dim3(512), args, LDS_BYTES, stream);
    if (e != hipSuccess) fprintf(stderr, "cooperative launch failed: %s (grid %d)\n", hipGetErrorString(e), grid_blocks);
}
```

```cpp
#include <hip/hip_runtime.h>
#include <hip/hip_cooperative_groups.h>
#include <cstdio>
#include <cstdint>
#include <cmath>
namespace cg = cooperative_groups;
namespace pg8 {
#define PG8_LAS __attribute__((address_space(3)))
typedef unsigned short bf16_t;
typedef short bf16x8 __attribute__((ext_vector_type(8)));
typedef float f32x4 __attribute__((ext_vector_type(4)));
typedef unsigned u32x4 __attribute__((ext_vector_type(4)));
constexpr int BM = 256, BK = 64, HALF = 128, HTB = HALF * BK * 2  , STAGE_BYTES = 8 * HTB, NXCD = 8, WGM = 8;

__host__ __device__ __forceinline__ int lds_byte(int r, int c) { const int st = (r >> 4) * 2 + (c >> 5), rr = r & 15, cc = c & 31, ob = rr * 64 + cc * 2; return st * 1024 + (ob ^ (((ob >> 9) & 1) << 5)); }
__host__ __device__ __forceinline__ void stage_rc(int b, int& R, int& C) { const int st = b / 1024, sb = b % 1024, swz = sb ^ (((sb >> 9) & 1) << 5); R = (st >> 1) * 16 + swz / 64; C = (st & 1) * 32 + (swz % 64) / 2; }
__host__ __device__ __forceinline__ int perm32(int rho) { const int n = rho >> 4, i = rho & 15; return 8 * (i >> 2) + 4 * n + (i & 3); }

struct Unit { int pm, pn; };
struct Gemm { const bf16_t* A; const bf16_t* Bt; int M, N, K; };

struct StaticOrder {
    int nM, nN, nwg, G, c;
    __host__ __device__ void init(int M, int N, int G_, int c_) { nM = M / BM; nN = N / BM; nwg = nM * nN; G = G_; c = c_; }
    __host__ __device__ bool next(int i, Unit& u) const {
        const long L = (long)i * G + c; if (L >= nwg) return false;
        int wgid = (int)L; { const int q = nwg / NXCD, r = nwg % NXCD, xcd = wgid % NXCD, off = wgid / NXCD; wgid = (xcd < r ? xcd * (q + 1) : r * (q + 1) + (xcd - r) * q) + off; }
        const int nig = WGM * nN, gid = wgid / nig, fm = gid * WGM, gsz = (nM - fm) < WGM ? (nM - fm) : WGM;
        u.pm = fm + ((wgid % nig) % gsz); u.pn = (wgid % nig) / gsz; return true;
    }
    __device__ __forceinline__ void a_ready(const Unit&) const {}
    __device__ __forceinline__ void done(const Unit&) const {}
};


typedef float f32x2 __attribute__((ext_vector_type(2)));
typedef unsigned u32x2 __attribute__((ext_vector_type(2)));
typedef __bf16 bf16x2_t __attribute__((ext_vector_type(2)));
__device__ __forceinline__ unsigned cvt_pk_bf16(float lo, float hi) { f32x2 v = {lo, hi}; bf16x2_t b = __builtin_convertvector(v, bf16x2_t); return __builtin_bit_cast(unsigned, b); }
__device__ __forceinline__ float bf_lo(unsigned u) { return __uint_as_float(u << 16); }
__device__ __forceinline__ float bf_hi(unsigned u) { return __uint_as_float(u & 0xffff0000u); }
constexpr int DMODEL = 2048;
constexpr float RMS_EPS = 1e-6f;
constexpr float LOG2E = 1.4426950408889634f;
__device__ __forceinline__ float row_rstd(const float* ssq, int row) {
    const f32x4* p = (const f32x4*)(ssq + (size_t)row * 32);
    float s = 0.f;
#pragma unroll
    for (int i = 0; i < 8; ++i) { const f32x4 v = p[i]; s += (v[0] + v[1]) + (v[2] + v[3]); }
    return __builtin_amdgcn_rsqf(s * (1.0f / DMODEL) + RMS_EPS);
}
__device__ __forceinline__ void rows_rstd(const float* ssq, int row0, int fq, float scale, float (&rs)[2][4]) {
    f32x4 pa[2][4], pb[2][4];
#pragma unroll
    for (int ai = 0; ai < 2; ++ai)
#pragma unroll
        for (int m = 0; m < 4; ++m) { const f32x4* p = (const f32x4*)(ssq + (size_t)(row0 + ai * HALF + m * 16) * 32 + 8 * fq); pa[ai][m] = p[0]; pb[ai][m] = p[1]; }
#pragma unroll
    for (int ai = 0; ai < 2; ++ai)
#pragma unroll
        for (int m = 0; m < 4; ++m) { const f32x4 a = pa[ai][m], c = pb[ai][m]; float s = ((a[0] + a[1]) + (a[2] + a[3])) + ((c[0] + c[1]) + (c[2] + c[3]));
            s += __shfl_xor(s, 16); s += __shfl_xor(s, 32); rs[ai][m] = __builtin_amdgcn_rsqf(s * (1.0f / DMODEL) + RMS_EPS) * scale; }
}
__device__ __forceinline__ float silu_f(float x) { return x * __builtin_amdgcn_rcpf(1.0f + __builtin_amdgcn_exp2f(-x * LOG2E)); }
__device__ __forceinline__ float sigmoid_f(float x) { return __builtin_amdgcn_rcpf(1.0f + __builtin_amdgcn_exp2f(-x * LOG2E)); }

struct EpiSwiglu {
    static constexpr bool PERM = true, AFTER_DRAIN = false;
    bf16_t* O; int ldo; const float* ssq;
    __device__ __forceinline__ void operator()(const f32x4 (&acc)[2][2][4][2], const Unit& u, int wr, int wc, int fr, int fq) const {
        const int row0 = u.pm * BM + wr * 64 + fr, col0 = u.pn * HALF + wc * 32 + 8 * fq;
        float rs[2][4];
        rows_rstd(ssq, row0, fq, 1.0f, rs);
#pragma unroll
        for (int ai = 0; ai < 2; ++ai)
#pragma unroll
            for (int m = 0; m < 4; ++m) { const int row = row0 + ai * HALF + m * 16; const float r = rs[ai][m];
                const f32x4 g0 = acc[ai][0][m][0] * r, g1 = acc[ai][0][m][1] * r, u0 = acc[ai][1][m][0] * r, u1 = acc[ai][1][m][1] * r;
                u32x4 w;
                w.x = cvt_pk_bf16(silu_f(g0[0]) * u0[0], silu_f(g0[1]) * u0[1]); w.y = cvt_pk_bf16(silu_f(g0[2]) * u0[2], silu_f(g0[3]) * u0[3]);
                w.z = cvt_pk_bf16(silu_f(g1[0]) * u1[0], silu_f(g1[1]) * u1[1]); w.w = cvt_pk_bf16(silu_f(g1[2]) * u1[2], silu_f(g1[3]) * u1[3]);
                *(u32x4*)(O + (size_t)row * ldo + col0) = w; }
    }
};
struct EpiRes {
    static constexpr bool PERM = false, AFTER_DRAIN = false;
    const float* base; float* out; bf16_t* outb; float* ssq_out; float alpha;
    __device__ __forceinline__ void operator()(const f32x4 (&acc)[2][2][4][2], const Unit& u, int wr, int wc, int fr, int fq) const {
        const int row0 = u.pm * BM + wr * 64 + fr, col0 = u.pn * BM + wc * 32 + 4 * fq;
#pragma unroll
        for (int ai = 0; ai < 2; ++ai) {
            f32x4 bs[4][2][2];
#pragma unroll
            for (int m = 0; m < 4; ++m)
#pragma unroll
                for (int bj = 0; bj < 2; ++bj)
#pragma unroll
                    for (int n = 0; n < 2; ++n) bs[m][bj][n] = *(const f32x4*)(base + (size_t)(row0 + ai * HALF + m * 16) * DMODEL + col0 + bj * HALF + n * 16);
#pragma unroll
            for (int m = 0; m < 4; ++m) { const int row = row0 + ai * HALF + m * 16; const size_t off = (size_t)row * DMODEL + col0; float sq = 0.f;
#pragma unroll
                for (int bj = 0; bj < 2; ++bj)
#pragma unroll
                    for (int n = 0; n < 2; ++n) { const size_t o2 = off + bj * HALF + n * 16; const f32x4 o = bs[m][bj][n] + acc[ai][bj][m][n] * alpha;
                        *(f32x4*)(out + o2) = o; sq += (o[0] * o[0] + o[1] * o[1]) + (o[2] * o[2] + o[3] * o[3]);
                        if (outb) { u32x2 w; w.x = cvt_pk_bf16(o[0], o[1]); w.y = cvt_pk_bf16(o[2], o[3]); *(u32x2*)(outb + o2) = w; } }
                sq += __shfl_xor(sq, 16); sq += __shfl_xor(sq, 32);
                if (fq == 0) ssq_out[(size_t)row * 32 + u.pn * 4 + wc] = sq; }
        }
    }
};
struct EpiProj {
    static constexpr bool PERM = true, AFTER_DRAIN = false;
    bf16_t* O; int ldo; const float* ssq; float qa_scale, qb_scale; float* kpart;
    __device__ __forceinline__ void operator()(const f32x4 (&acc)[2][2][4][2], const Unit& u, int wr, int wc, int fr, int fq) const {
        const int row0 = u.pm * BM + wr * 64 + fr, col0 = u.pn * BM + wc * 32 + 8 * fq;
        const bool sig = u.pn >= 16; const float sc = u.pn < 4 ? qa_scale : ((u.pn >= 8 && u.pn < 12) ? qb_scale : 1.0f);
        float rs[2][4];
        rows_rstd(ssq, row0, fq, sc, rs);
#pragma unroll
        for (int ai = 0; ai < 2; ++ai)
#pragma unroll
            for (int m = 0; m < 4; ++m) { const int row = row0 + ai * HALF + m * 16; const float r = rs[ai][m];
#pragma unroll
                for (int bj = 0; bj < 2; ++bj) { f32x4 v0 = acc[ai][bj][m][0] * r, v1 = acc[ai][bj][m][1] * r;
                    if (sig) {
#pragma unroll
                        for (int j = 0; j < 4; ++j) { v0[j] = sigmoid_f(v0[j]); v1[j] = sigmoid_f(v1[j]); } }
                    u32x4 w; w.x = cvt_pk_bf16(v0[0], v0[1]); w.y = cvt_pk_bf16(v0[2], v0[3]); w.z = cvt_pk_bf16(v1[0], v1[1]); w.w = cvt_pk_bf16(v1[2], v1[3]);
                    *(u32x4*)(O + (size_t)row * ldo + col0 + bj * HALF) = w; } }
        if (u.pn >= 12 && u.pn < 16) {
#pragma unroll
            for (int bj = 0; bj < 2; ++bj) { f32x4 s0 = {0.f, 0.f, 0.f, 0.f}, s1 = {0.f, 0.f, 0.f, 0.f};
#pragma unroll
                for (int ai = 0; ai < 2; ++ai)
#pragma unroll
                    for (int m = 0; m < 4; ++m) { s0 += acc[ai][bj][m][0] * rs[ai][m]; s1 += acc[ai][bj][m][1] * rs[ai][m]; }
#pragma unroll
                for (int j = 0; j < 4; ++j) {
#pragma unroll
                    for (int o = 1; o < 16; o <<= 1) { s0[j] += __shfl_xor(s0[j], o); s1[j] += __shfl_xor(s1[j], o); } }
                if (fr == 0) { float* kp = kpart + ((size_t)u.pm * 2 + wr) * 1024 + (col0 - 3072) + bj * HALF; *(f32x4*)kp = s0; *(f32x4*)(kp + 4) = s1; } }
        }
    }
};
struct EpiVt {
    static constexpr bool PERM = true, AFTER_DRAIN = false;
    bf16_t* O; int ldo; const float* ssq;
    __device__ __forceinline__ void operator()(const f32x4 (&acc)[2][2][4][2], const Unit& u, int wr, int wc, int fr, int fq) const {
        const int row0 = u.pm * BM + wr * 64 + fr, col0 = u.pn * BM + wc * 32 + 8 * fq;
        f32x4 rs[2][2];
        {
            const float mine = row_rstd(ssq, u.pn * BM + (fr >> 3) * HALF + wc * 32 + 8 * fq + (fr & 7));
            const int lbase = fq * 16;
#pragma unroll
            for (int bj = 0; bj < 2; ++bj)
#pragma unroll
                for (int n = 0; n < 2; ++n)
#pragma unroll
                    for (int j = 0; j < 4; ++j) rs[bj][n][j] = __shfl(mine, lbase + bj * 8 + n * 4 + j);
        }
#pragma unroll
        for (int ai = 0; ai < 2; ++ai)
#pragma unroll
            for (int m = 0; m < 4; ++m) { const int row = row0 + ai * HALF + m * 16;
#pragma unroll
                for (int bj = 0; bj < 2; ++bj) { const f32x4 v0 = acc[ai][bj][m][0] * rs[bj][0], v1 = acc[ai][bj][m][1] * rs[bj][1];
                    u32x4 w; w.x = cvt_pk_bf16(v0[0], v0[1]); w.y = cvt_pk_bf16(v0[2], v0[3]); w.z = cvt_pk_bf16(v1[0], v1[1]); w.w = cvt_pk_bf16(v1[2], v1[3]);
                    *(u32x4*)(O + (size_t)row * ldo + col0 + bj * HALF) = w; } }
    }
};
template <bool FIRST> struct EpiGate {
    static constexpr bool PERM = true, AFTER_DRAIN = false;
    bf16_t* T; const bf16_t* sig; int ldsig;
    __device__ __forceinline__ void operator()(const f32x4 (&acc)[2][2][4][2], const Unit& u, int wr, int wc, int fr, int fq) const {
        const int row0 = u.pm * BM + wr * 64 + fr, col0 = u.pn * BM + wc * 32 + 8 * fq;
#pragma unroll
        for (int ai = 0; ai < 2; ++ai) {
            u32x4 sg[4][2], tt[4][2];
#pragma unroll
            for (int m = 0; m < 4; ++m)
#pragma unroll
                for (int bj = 0; bj < 2; ++bj) { const int row = row0 + ai * HALF + m * 16, col = col0 + bj * HALF;
                    sg[m][bj] = *(const u32x4*)(sig + (size_t)row * ldsig + col);
                    if (!FIRST) tt[m][bj] = *(const u32x4*)(T + (size_t)row * DMODEL + col); }
#pragma unroll
            for (int m = 0; m < 4; ++m) { const int row = row0 + ai * HALF + m * 16;
#pragma unroll
                for (int bj = 0; bj < 2; ++bj) { const int col = col0 + bj * HALF;
                    const u32x4 s = sg[m][bj];
                    const f32x4 a0 = acc[ai][bj][m][0], a1 = acc[ai][bj][m][1];
                    float v[8];
                    v[0] = bf_lo(s.x) * a0[0]; v[1] = bf_hi(s.x) * a0[1]; v[2] = bf_lo(s.y) * a0[2]; v[3] = bf_hi(s.y) * a0[3];
                    v[4] = bf_lo(s.z) * a1[0]; v[5] = bf_hi(s.z) * a1[1]; v[6] = bf_lo(s.w) * a1[2]; v[7] = bf_hi(s.w) * a1[3];
                    bf16_t* tp = T + (size_t)row * DMODEL + col;
                    if (!FIRST) { const u32x4 t = tt[m][bj];
                        v[0] += bf_lo(t.x); v[1] += bf_hi(t.x); v[2] += bf_lo(t.y); v[3] += bf_hi(t.y); v[4] += bf_lo(t.z); v[5] += bf_hi(t.z); v[6] += bf_lo(t.w); v[7] += bf_hi(t.w); }
                    u32x4 w; w.x = cvt_pk_bf16(v[0], v[1]); w.y = cvt_pk_bf16(v[2], v[3]); w.z = cvt_pk_bf16(v[4], v[5]); w.w = cvt_pk_bf16(v[6], v[7]);
                    *(u32x4*)tp = w; } }
        }
    }
};

struct EpiResNorm {
    static constexpr bool PERM = false, AFTER_DRAIN = true;
    const float* base; float* out; const float* gain; float alpha; float* xs; unsigned* cnt;
    __device__ __forceinline__ void operator()(const f32x4 (&)[2][2][4][2], const Unit&, int, int, int, int) const {}
    __device__ __forceinline__ void fused(f32x4 (&acc)[2][2][4][2], const Unit& u, int wr, int wc, int fr, int fq, PG8_LAS unsigned char* lds, int wid, int lane) const {
        PG8_LAS float* P = (PG8_LAS float*)lds;
        PG8_LAS float* S = (PG8_LAS float*)(lds + 8192);
        const int row0 = u.pm * BM + wr * 64 + fr, col0 = u.pn * BM + wc * 32 + 4 * fq;
#pragma unroll
        for (int ai = 0; ai < 2; ++ai) {
            f32x4 bs[4][2][2];
#pragma unroll
            for (int m = 0; m < 4; ++m)
#pragma unroll
                for (int bj = 0; bj < 2; ++bj)
#pragma unroll
                    for (int n = 0; n < 2; ++n) bs[m][bj][n] = *(const f32x4*)(base + (size_t)(row0 + ai * HALF + m * 16) * DMODEL + col0 + bj * HALF + n * 16);
#pragma unroll
            for (int m = 0; m < 4; ++m) { float sq = 0.f;
#pragma unroll
                for (int bj = 0; bj < 2; ++bj)
#pragma unroll
                    for (int n = 0; n < 2; ++n) { const f32x4 o = bs[m][bj][n] + acc[ai][bj][m][n] * alpha; acc[ai][bj][m][n] = o; sq += (o[0] * o[0] + o[1] * o[1]) + (o[2] * o[2] + o[3] * o[3]); }
                sq += __shfl_xor(sq, 16); sq += __shfl_xor(sq, 32);
                if (fq == 0) P[(ai * HALF + wr * 64 + m * 16 + fr) * 4 + wc] = sq; }
        }
        asm volatile("s_waitcnt lgkmcnt(0)" ::: "memory"); __builtin_amdgcn_s_barrier(); asm volatile("" ::: "memory");
        const int row = wid * 32 + (lane & 31);
        if (lane < 32) { const float t = (P[row * 4 + 0] + P[row * 4 + 1]) + (P[row * 4 + 2] + P[row * 4 + 3]);
            __hip_atomic_store(xs + (size_t)(u.pm * BM + row) * 8 + u.pn, t, __ATOMIC_RELAXED, __HIP_MEMORY_SCOPE_AGENT); }
        asm volatile("s_waitcnt vmcnt(0)" ::: "memory");
        if (lane == 0) __hip_atomic_fetch_add(cnt + 64 * u.pm, 1u, __ATOMIC_RELAXED, __HIP_MEMORY_SCOPE_AGENT);
        if (wid == 0) {
            for (unsigned sp = 0; sp < (1u << 22); ++sp) {
                if ((unsigned)__builtin_amdgcn_readfirstlane(__hip_atomic_load(cnt + 64 * u.pm, __ATOMIC_RELAXED, __HIP_MEMORY_SCOPE_AGENT)) >= 64u) break;
                __builtin_amdgcn_s_sleep(2);
            }
            __builtin_amdgcn_fence(__ATOMIC_ACQUIRE, "agent");
        }
        asm volatile("s_waitcnt vmcnt(0) lgkmcnt(0)" ::: "memory"); __builtin_amdgcn_s_barrier(); asm volatile("" ::: "memory");
        if (lane < 32) { const float* sl = xs + (size_t)(u.pm * BM + row) * 8; float t[8];
#pragma unroll
            for (int i = 0; i < 8; ++i) t[i] = __hip_atomic_load(sl + i, __ATOMIC_RELAXED, __HIP_MEMORY_SCOPE_AGENT);
            const float tot = ((t[0] + t[1]) + (t[2] + t[3])) + ((t[4] + t[5]) + (t[6] + t[7]));
            S[row] = __builtin_amdgcn_rsqf(tot * (1.0f / DMODEL) + RMS_EPS); }
        asm volatile("s_waitcnt lgkmcnt(0)" ::: "memory"); __builtin_amdgcn_s_barrier(); asm volatile("" ::: "memory");
        f32x4 gv[2][2];
#pragma unroll
        for (int bj = 0; bj < 2; ++bj)
#pragma unroll
            for (int n = 0; n < 2; ++n) gv[bj][n] = *(const f32x4*)(gain + col0 + bj * HALF + n * 16);
#pragma unroll
        for (int ai = 0; ai < 2; ++ai)
#pragma unroll
            for (int m = 0; m < 4; ++m) { const int rl = ai * HALF + wr * 64 + m * 16 + fr; const float rs = S[rl]; const size_t off = (size_t)(u.pm * BM + rl) * DMODEL + col0;
#pragma unroll
                for (int bj = 0; bj < 2; ++bj)
#pragma unroll
                    for (int n = 0; n < 2; ++n) *(f32x4*)(out + off + bj * HALF + n * 16) = acc[ai][bj][m][n] * rs * gv[bj][n]; }
    }
};

template <class Epi, class Sched, bool ALIGN_EPI = false, bool SP2 = false>
__device__ __forceinline__ void gemm_phase(PG8_LAS unsigned char* lds, const Gemm g, const Sched& S, const Epi& E) {
    int tid_o = threadIdx.x; asm volatile("" : "+v"(tid_o));
    const int tid = tid_o, wid = __builtin_amdgcn_readfirstlane(tid >> 6), lane = tid & 63, wr = wid >> 2, wc = wid & 3, fr = lane & 15, fq = lane >> 4;
    const int K = g.K, nt = K / BK;
    unsigned voffA[2], voffB[2];
#pragma unroll
    for (int i = 0; i < 2; ++i) { int R, C; stage_rc(tid * 16 + i * 8192, R, C); const int Rb = Epi::PERM ? ((R & ~31) + perm32(R & 31)) : R;
        voffA[i] = (unsigned)(R * K + C) * 2u; voffB[i] = (unsigned)(Rb * K + C) * 2u; }
    const size_t kstep = (size_t)(BK * 2);
    const size_t hstep = (size_t)HALF * K * 2;
    const size_t tstep = 2 * hstep;
    const unsigned ldsw = (unsigned)wid * 1024u;
    const int aoff = lds_byte(wr * 64 + fr, fq * 8), boff = lds_byte(wc * 32 + fr, fq * 8);
#define PG8_SA(b, h) (((b) * 2 + (h)) * HTB)
#define PG8_SB(b, h) ((4 + (b) * 2 + (h)) * HTB)
#define PG8_STAGE(bufoff, gbase, voff) do { _Pragma("unroll") for (int _i = 0; _i < 2; ++_i) \
        __builtin_amdgcn_global_load_lds((const unsigned*)((const char*)(gbase) + (voff)[_i]), (PG8_LAS unsigned*)(lds + (bufoff) + ldsw + _i * 8192), 16, 0, 0); } while (0)
#define PG8_LDA(dst, b, h) do { _Pragma("unroll") for (int m = 0; m < 4; ++m) _Pragma("unroll") for (int k = 0; k < 2; ++k) dst[m][k] = *(const PG8_LAS bf16x8*)(lds + PG8_SA(b, h) + aoff + m * 2048 + k * 1024); } while (0)
#define PG8_LDB(dst, b, h) do { _Pragma("unroll") for (int n = 0; n < 2; ++n) _Pragma("unroll") for (int k = 0; k < 2; ++k) dst[n][k] = *(const PG8_LAS bf16x8*)(lds + PG8_SB(b, h) + boff + n * 2048 + k * 1024); } while (0)
#define PG8_MMA(ai, bj, At, Bt) do { __builtin_amdgcn_s_setprio(1); _Pragma("unroll") for (int m = 0; m < 4; ++m) _Pragma("unroll") for (int n = 0; n < 2; ++n) _Pragma("unroll") for (int k = 0; k < 2; ++k) \
        acc[ai][bj][m][n] = __builtin_amdgcn_mfma_f32_16x16x32_bf16(Bt[n][k], At[m][k], acc[ai][bj][m][n], 0, 0, 0); __builtin_amdgcn_s_setprio(0); } while (0)
#define PG8_WAIT_V(n) asm volatile("s_waitcnt vmcnt(" #n ")" ::: "memory")
#define PG8_WAIT_L(n) asm volatile("s_waitcnt lgkmcnt(" #n ")" ::: "memory")
#define PG8_BAR __builtin_amdgcn_s_barrier()
#define PG8_SCHED __builtin_amdgcn_sched_barrier(0)
    Unit cur, nxt; int ui = 0;
    if (!S.next(0, cur)) return;
    f32x4 acc[2][2][4][2];
#pragma unroll
    for (int a = 0; a < 2; ++a)
#pragma unroll
        for (int b = 0; b < 2; ++b)
#pragma unroll
            for (int m = 0; m < 4; ++m)
#pragma unroll
                for (int n = 0; n < 2; ++n) acc[a][b][m][n] = (f32x4){0.f, 0.f, 0.f, 0.f};
    bf16x8 At[4][2], B0[2][2], B1[2][2];
    const char* cA = (const char*)g.A + (size_t)cur.pm * tstep; const char* cB = (const char*)g.Bt + (size_t)cur.pn * tstep;
    S.a_ready(cur);
    if constexpr (SP2) {
        PG8_STAGE(PG8_SB(0, 0), cB, voffB); PG8_STAGE(PG8_SB(0, 1), cB + hstep, voffB); PG8_STAGE(PG8_SA(0, 0), cA, voffA); PG8_STAGE(PG8_SA(0, 1), cA + hstep, voffA);
        if (wr == 1) PG8_BAR;
        PG8_WAIT_V(2); PG8_BAR;
        PG8_STAGE(PG8_SB(1, 0), cB + kstep, voffB); PG8_STAGE(PG8_SA(1, 0), cA + kstep, voffA); PG8_STAGE(PG8_SB(1, 1), cB + hstep + kstep, voffB);
        PG8_WAIT_V(6); PG8_BAR;
    } else {
        PG8_STAGE(PG8_SB(0, 0), cB, voffB); PG8_STAGE(PG8_SA(0, 0), cA, voffA); PG8_STAGE(PG8_SB(0, 1), cB + hstep, voffB); PG8_STAGE(PG8_SA(0, 1), cA + hstep, voffA);
        if (wr == 1) PG8_BAR;
        PG8_WAIT_V(4); PG8_BAR;
        PG8_STAGE(PG8_SB(1, 0), cB + kstep, voffB); PG8_STAGE(PG8_SA(1, 0), cA + kstep, voffA); PG8_STAGE(PG8_SB(1, 1), cB + hstep + kstep, voffB);
        PG8_WAIT_V(6); PG8_BAR;
    }
    for (;;) {
        const bool has_next = S.next(ui + 1, nxt);
        const char* nA = has_next ? (const char*)g.A + (size_t)nxt.pm * tstep : cA; const char* nB = has_next ? (const char*)g.Bt + (size_t)nxt.pn * tstep : cB;
        for (int t = 0; t < nt; t += 2) {
            const bool last = (t == nt - 2);
            const char* a1 = cA + (size_t)(t + 1) * kstep;
            const char* a2 = last ? nA : cA + (size_t)(t + 2) * kstep; const char* b2 = last ? nB : cB + (size_t)(t + 2) * kstep;
            const char* a3 = a2 + kstep; const char* b3 = b2 + kstep;
            if (last && has_next) S.a_ready(nxt);
            if constexpr (SP2) {
            PG8_LDB(B0, 0, 0); PG8_LDB(B1, 0, 1); PG8_SCHED; PG8_LDA(At, 0, 0); PG8_STAGE(PG8_SA(1, 1), a1 + hstep, voffA);
            PG8_WAIT_V(8); PG8_WAIT_L(0); PG8_BAR; PG8_MMA(0, 0, At, B0); PG8_MMA(0, 1, At, B1); PG8_BAR; PG8_SCHED;
            PG8_LDA(At, 0, 1); PG8_STAGE(PG8_SB(0, 0), b2, voffB); PG8_STAGE(PG8_SB(0, 1), b2 + hstep, voffB); PG8_STAGE(PG8_SA(0, 0), a2, voffA);
            PG8_WAIT_V(8); PG8_WAIT_L(0); PG8_BAR; PG8_MMA(1, 0, At, B0); PG8_MMA(1, 1, At, B1); PG8_BAR; PG8_SCHED;
            PG8_LDB(B0, 1, 0); PG8_LDB(B1, 1, 1); PG8_SCHED; PG8_LDA(At, 1, 0); PG8_STAGE(PG8_SA(0, 1), a2 + hstep, voffA);
            PG8_WAIT_V(8); PG8_WAIT_L(0); PG8_BAR; PG8_MMA(0, 0, At, B0); PG8_MMA(0, 1, At, B1); PG8_BAR; PG8_SCHED;
            PG8_LDA(At, 1, 1); PG8_STAGE(PG8_SB(1, 0), b3, voffB); PG8_STAGE(PG8_SB(1, 1), b3 + hstep, voffB); PG8_STAGE(PG8_SA(1, 0), a3, voffA);
            PG8_WAIT_V(8); PG8_WAIT_L(0); PG8_BAR; PG8_MMA(1, 0, At, B0); PG8_MMA(1, 1, At, B1); PG8_BAR; PG8_SCHED;
            } else {
            PG8_LDB(B0, 0, 0); PG8_SCHED; PG8_LDA(At, 0, 0); PG8_STAGE(PG8_SA(1, 1), a1 + hstep, voffA);
            PG8_WAIT_L(8); PG8_BAR; PG8_WAIT_L(0); PG8_MMA(0, 0, At, B0); PG8_BAR; PG8_SCHED;
            PG8_LDB(B1, 0, 1); PG8_STAGE(PG8_SB(0, 0), b2, voffB);
            PG8_BAR; PG8_WAIT_L(0); PG8_MMA(0, 1, At, B1); PG8_BAR;
            PG8_LDA(At, 0, 1); PG8_STAGE(PG8_SA(0, 0), a2, voffA);
            PG8_BAR; PG8_WAIT_L(0); PG8_MMA(1, 0, At, B0); PG8_BAR; PG8_SCHED;
            PG8_STAGE(PG8_SB(0, 1), b2 + hstep, voffB);
            PG8_WAIT_V(6); PG8_BAR; PG8_MMA(1, 1, At, B1); PG8_BAR;
            PG8_LDB(B0, 1, 0); PG8_SCHED; PG8_LDA(At, 1, 0); PG8_STAGE(PG8_SA(0, 1), a2 + hstep, voffA);
            PG8_WAIT_L(8); PG8_BAR; PG8_WAIT_L(0); PG8_MMA(0, 0, At, B0); PG8_BAR; PG8_SCHED;
            PG8_LDB(B1, 1, 1); PG8_STAGE(PG8_SB(1, 0), b3, voffB);
            PG8_BAR; PG8_WAIT_L(0); PG8_MMA(0, 1, At, B1); PG8_BAR;
            PG8_LDA(At, 1, 1); PG8_STAGE(PG8_SA(1, 0), a3, voffA);
            PG8_BAR; PG8_WAIT_L(0); PG8_MMA(1, 0, At, B0); PG8_BAR; PG8_SCHED;
            PG8_STAGE(PG8_SB(1, 1), b3 + hstep, voffB);
            PG8_WAIT_V(6); PG8_BAR; PG8_MMA(1, 1, At, B1); PG8_BAR;
            }
        }
        if constexpr (ALIGN_EPI) { if (wr == 0) PG8_BAR; }
        if constexpr (!Epi::AFTER_DRAIN) { E(acc, cur, wr, wc, fr, fq); S.done(cur); }
        if (!has_next) break;
#pragma unroll
        for (int a = 0; a < 2; ++a)
#pragma unroll
            for (int b = 0; b < 2; ++b)
#pragma unroll
                for (int m = 0; m < 4; ++m)
#pragma unroll
                    for (int n = 0; n < 2; ++n) acc[a][b][m][n] = (f32x4){0.f, 0.f, 0.f, 0.f};
        cur = nxt; cA = nA; cB = nB; ++ui;
        if constexpr (ALIGN_EPI) { if (wr == 1) PG8_BAR; }
    }
    PG8_WAIT_V(0);
    if constexpr (!ALIGN_EPI) { if (wr == 0) PG8_BAR; }
    PG8_BAR;
    if constexpr (Epi::AFTER_DRAIN) { E.fused(acc, cur, wr, wc, fr, fq, lds, wid, lane); S.done(cur); }
#undef PG8_SA
#undef PG8_SB
#undef PG8_STAGE
#undef PG8_LDA
#undef PG8_LDB
#undef PG8_MMA
#undef PG8_WAIT_V
#undef PG8_WAIT_L
#undef PG8_BAR
#undef PG8_SCHED
}
}

using namespace pg8;
#define LAS __attribute__((address_space(3)))
typedef float f32x16 __attribute__((ext_vector_type(16)));

constexpr int BATCH = 4, SEQ = 2048, M_TOK = BATCH * SEQ, DFF = 5632;
constexpr int PJ_LD = 8192;
constexpr int VT_LD = M_TOK;
constexpr float QA_SCALE = 0.125f * LOG2E, QB_SCALE = 0.08838834764831845f * LOG2E;

constexpr size_t MiB = 1u << 20;
constexpr size_t WS_SSQ0 = 0, WS_SSQ1 = 1 * MiB, WS_SSQ2 = 2 * MiB, WS_SSQ3 = 3 * MiB, WS_KMEAN = 4 * MiB, WS_XS = 4 * MiB + 512 * 1024, WS_BAR = 5 * MiB, BAR_BYTES = 32768;
constexpr size_t WS_WGU = 8 * MiB, WS_WDN = 52 * MiB, WS_WIN = 74 * MiB, WS_WV = 106 * MiB, WS_WPA = 114 * MiB, WS_WPB = 118 * MiB, WS_WO = 122 * MiB;
constexpr size_t WS_XB = 130 * MiB, WS_ACT = 162 * MiB, WS_OA = WS_ACT, WS_OB = WS_ACT + 16 * MiB, WS_PJ = 250 * MiB, WS_VT = 378 * MiB, WS_END = 410 * MiB;
constexpr size_t WS_WGU1 = WS_PJ, WS_WDN1 = WS_PJ + 44 * MiB;

constexpr int TAIL1_EXTRA = 7168;
constexpr int WGU2_EARLY = 0;
constexpr int LDS_BYTES = 147456;

__device__ __forceinline__ float wave_sum(float v) {
#pragma unroll
    for (int o = 1; o < 64; o <<= 1) v += __shfl_xor(v, o);
    return v;
}
struct ConvDesc { const float* src; bf16_t* dst; const float* g; int Nsrc, K; };
#ifndef CONV_MODE
#define CONV_MODE 1
#endif
__device__ __forceinline__ ConvDesc conv_desc(const float* W, int K, int Nsrc, int c0, int nc, bf16_t* WT, int r0, const float* g, int mode, int item) {
    const int nblk = nc / 64;
    int kb, nb;
    if (CONV_MODE == 0) { kb = item / nblk; nb = item % nblk; }
    else { const int j = item & 7, t = item >> 3; nb = t % nblk; kb = (t / nblk) * 8 + j; }
    const int loc = 64 * nb;
    int dst = r0 + loc;
    if (mode == 1) { const int half = nc / 2; const int l2 = loc < half ? loc : loc - half; dst = r0 + 256 * (l2 / 128) + (l2 % 128) + (loc < half ? 0 : 128); }
    ConvDesc d; d.src = W + (size_t)(64 * kb) * Nsrc + c0 + loc; d.dst = WT + (size_t)dst * K + 64 * kb; d.g = g ? g + 64 * kb : nullptr; d.Nsrc = Nsrc; d.K = K;
    return d;
}
__device__ __forceinline__ void conv_load(const ConvDesc& d, f32x4 (&v)[16], int lane) {
    const int kq = lane >> 4, n4 = (lane & 15) * 4;
    const float* src = d.src + (size_t)(2 * kq) * d.Nsrc + n4;
#pragma unroll
    for (int i = 0; i < 8; ++i) { v[2 * i] = __builtin_nontemporal_load((const f32x4*)(src + (size_t)(8 * i) * d.Nsrc)); v[2 * i + 1] = __builtin_nontemporal_load((const f32x4*)(src + (size_t)(8 * i + 1) * d.Nsrc)); }
}
__device__ __forceinline__ void conv_scatter(const ConvDesc& d, f32x4 (&v)[16], LAS unsigned* scr, int lane) {
    const int kq = lane >> 4, n4 = (lane & 15) * 4;
    if (d.g) {
#pragma unroll
        for (int i = 0; i < 8; ++i) { const f32x2 gg = *(const f32x2*)(d.g + 8 * i + 2 * kq); v[2 * i] = v[2 * i] * gg.x; v[2 * i + 1] = v[2 * i + 1] * gg.y; } }
#pragma unroll
    for (int i = 0; i < 8; ++i)
#pragma unroll
        for (int j = 0; j < 4; ++j) scr[(n4 + j) * 33 + 4 * i + kq] = cvt_pk_bf16(v[2 * i][j], v[2 * i + 1][j]);
}
__device__ __forceinline__ void conv_store(const ConvDesc& d, const LAS unsigned* scr, int lane) {
    const int c = lane & 7, nl = lane >> 3;
#pragma unroll
    for (int jj = 0; jj < 8; ++jj) { const int n = nl + 8 * jj; const LAS unsigned* sp = scr + n * 33 + 4 * c;
        u32x4 o; o.x = sp[0]; o.y = sp[1]; o.z = sp[2]; o.w = sp[3];
        *(u32x4*)(d.dst + (size_t)n * d.K + 8 * c) = o; }
}
__device__ __forceinline__ void conv_pair(const ConvDesc& A, const ConvDesc& B, bool hasB, LAS unsigned* scr, int lane) {
    f32x4 va[16], vb[16];
    conv_load(A, va, lane);
    if (hasB) conv_load(B, vb, lane);
    conv_scatter(A, va, scr, lane);
    if (hasB) conv_scatter(B, vb, scr + 2112, lane);
    asm volatile("s_waitcnt lgkmcnt(0)" ::: "memory");
    conv_store(A, scr, lane);
    if (hasB) conv_store(B, scr + 2112, lane);
    asm volatile("s_waitcnt lgkmcnt(0)" ::: "memory");
}

constexpr int ATT_KPMAX = 272, ATT_VP = 144;
constexpr int ATT_LDS_KB = 64 * ATT_KPMAX, ATT_LDS_V0 = 2 * ATT_LDS_KB, ATT_LDS_VB = 128 * ATT_VP;
constexpr float ATT_NEG = -1e30f;
#define MFMA32(a, b, c) __builtin_amdgcn_mfma_f32_32x32x16_bf16((a), (b), (c), 0, 0, 0)

template <int DH, bool MOBA>
__device__ __forceinline__ void flash_pass(LAS unsigned char* lds, const bf16_t* qrow, const bf16_t* kbase, const bf16_t* vtbase, int q0, int qblk, float sl2, unsigned sel, f32x16 (&o)[4], int tid) {
    const int lane = tid & 63, r32 = lane & 31, hi = lane >> 5, wid = __builtin_amdgcn_readfirstlane(tid >> 6);
    constexpr int KP = DH * 2 + 16, KPIECES = DH / 8, KLD = (64 * KPIECES) / 512;
    bf16x8 qf[DH / 16];
#pragma unroll
    for (int d0 = 0; d0 < DH / 16; ++d0) qf[d0] = *(const bf16x8*)(qrow + d0 * 16 + hi * 8);
    const int qw0 = q0 + wid * 32, qpos = qw0 + r32;
    float m_run = 0.f, l_run = 0.f;
#pragma unroll
    for (int d = 0; d < 4; ++d)
#pragma unroll
        for (int r = 0; r < 16; ++r) o[d][r] = 0.f;
    const int NT = 4 * (qblk + 1);
    const int pg = r32 >> 3, phh = (r32 >> 2) & 1, pt = r32 & 3, prow = 16 * (pg >> 1) + 8 * phh + 4 * (pg & 1) + pt;
    const unsigned kfo = prow * KP + hi * 16, vfo = r32 * ATT_VP + hi * 16;
    u32x4 kreg[KLD], vreg[2];
#define TILE_OF(i) (MOBA ? ((((i) < 4) ? qblk : (((i) >> 2) - 1)) * 4 + ((i) & 3)) : (i))
#define LOADG(tile) do { const int kv0_ = (tile) * 64; \
        _Pragma("unroll") for (int j = 0; j < KLD; ++j) { const int p = tid + 512 * j, row = p / KPIECES, c = p % KPIECES; kreg[j] = *(const u32x4*)(kbase + (size_t)(kv0_ + row) * PJ_LD + c * 8); } \
        _Pragma("unroll") for (int j = 0; j < 2; ++j) { const int p = tid + 512 * j, d = p >> 3, c = p & 7; vreg[j] = *(const u32x4*)(vtbase + (size_t)d * VT_LD + kv0_ + c * 8); } } while (0)
#define STORE_LDS(buf) do { \
        _Pragma("unroll") for (int j = 0; j < KLD; ++j) { const int p = tid + 512 * j, row = p / KPIECES, c = p % KPIECES; *(LAS u32x4*)(lds + (buf) * ATT_LDS_KB + row * KP + c * 16) = kreg[j]; } \
        _Pragma("unroll") for (int j = 0; j < 2; ++j) { const int p = tid + 512 * j, d = p >> 3, c = p & 7; *(LAS u32x4*)(lds + ATT_LDS_V0 + (buf) * ATT_LDS_VB + d * ATT_VP + c * 16) = vreg[j]; } } while (0)
    LOADG(TILE_OF(0)); STORE_LDS(0); __syncthreads();
#pragma unroll 1
    for (int i = 0; i < NT; ++i) {
        const int tile = TILE_OF(i), kv0 = tile * 64, blk = tile >> 2, buf = i & 1;
        { const int in_ = (i + 1 < NT) ? i + 1 : i; LOADG(TILE_OF(in_)); }
        const bool diag = (blk == qblk);
        bool active = !(diag && kv0 > qw0 + 31);
        const bool mysel = MOBA ? (((sel >> blk) & 1u) != 0u) : true;
        if (MOBA && !diag) { if (!__any(mysel ? 1 : 0)) active = false; }
        if (active) {
            const LAS unsigned char* Kb = lds + buf * ATT_LDS_KB; const LAS unsigned char* Vb = lds + ATT_LDS_V0 + buf * ATT_LDS_VB;
            f32x16 s[2];
            const float fb = sl2 * (float)(kv0 + 8 * hi - qpos) - m_run;
            const int thr = qpos - kv0 - 8 * hi;
            const bool need = (diag && kv0 + 63 > qw0) || (MOBA && !diag && !__all(mysel ? 1 : 0));
            int thr_eff = diag ? thr : 4096;
            if (MOBA) thr_eff = (!diag && !mysel) ? -4096 : thr_eff;
            constexpr int NQK = DH / 16, PER = 16 / NQK;
            {
                const float fb0 = fb, fb1 = fb + sl2 * 16.0f;
#pragma unroll
                for (int r = 0; r < 16; ++r) s[0][r] = ((r >> 3) ? fb1 : fb0) + sl2 * (float)(r & 7);
            }
            const float fb2 = fb + sl2 * 32.0f, fb3 = fb + sl2 * 48.0f;
            __builtin_amdgcn_s_setprio(1);
#pragma unroll
            for (int g0 = 0; g0 < NQK; g0 += 4) {
                bf16x8 kf[4];
#pragma unroll
                for (int j4 = 0; j4 < 4; ++j4) kf[j4] = *(const LAS bf16x8*)(Kb + kfo + (g0 + j4) * 32);
#pragma unroll
                for (int j4 = 0; j4 < 4; ++j4) { const int d0 = g0 + j4;
                    s[0] = MFMA32(kf[j4], qf[d0], s[0]);
#pragma unroll
                    for (int j = 0; j < PER; ++j) { const int r = d0 * PER + j; s[1][r] = ((r >> 3) ? fb3 : fb2) + sl2 * (float)(r & 7); }
                }
                __builtin_amdgcn_sched_barrier(0);
            }
            __builtin_amdgcn_s_setprio(0);
            if (need) {
#pragma unroll
                for (int r = 0; r < 16; ++r) s[0][r] = (16 * (r >> 3) + (r & 7) > thr_eff) ? ATT_NEG : s[0][r];
            }
            float mx = fmaxf(fmaxf(s[0][0], s[0][1]), s[0][2]);
#pragma unroll
            for (int r = 3; r < 15; r += 2) mx = fmaxf(fmaxf(mx, s[0][r]), s[0][r + 1]);
            mx = fmaxf(mx, s[0][15]);
            __builtin_amdgcn_sched_barrier(0);
            __builtin_amdgcn_s_setprio(1);
#pragma unroll
            for (int g0 = 0; g0 < NQK; g0 += 4) {
                bf16x8 kf[4];
#pragma unroll
                for (int j4 = 0; j4 < 4; ++j4) kf[j4] = *(const LAS bf16x8*)(Kb + kfo + 32 * KP + (g0 + j4) * 32);
#pragma unroll
                for (int j4 = 0; j4 < 4; ++j4) { const int d0 = g0 + j4;
                    s[1] = MFMA32(kf[j4], qf[d0], s[1]);
#pragma unroll
                    for (int j = 0; j < PER; ++j) { const int r = d0 * PER + j; s[0][r] = __builtin_amdgcn_exp2f(s[0][r]); asm volatile("" : "+v"(s[0][r])); }
                    __builtin_amdgcn_sched_barrier(0);
                }
            }
            __builtin_amdgcn_s_setprio(0);
            if (need) {
#pragma unroll
                for (int r = 0; r < 16; ++r) s[1][r] = (32 + 16 * (r >> 3) + (r & 7) > thr_eff) ? ATT_NEG : s[1][r];
            }
            mx = fmaxf(fmaxf(mx, s[1][0]), s[1][1]);
#pragma unroll
            for (int r = 2; r < 16; r += 2) mx = fmaxf(fmaxf(mx, s[1][r]), s[1][r + 1]);
            mx = fmaxf(mx, __shfl_xor(mx, 32));
            if (__any(mx > 8.0f ? 1 : 0)) {
                const float dl = fmaxf(mx, 0.f), alpha = __builtin_amdgcn_exp2f(-dl);
                m_run += dl; l_run *= alpha;
#pragma unroll
                for (int d = 0; d < 4; ++d)
#pragma unroll
                    for (int r = 0; r < 16; ++r) o[d][r] *= alpha;
#pragma unroll
                for (int r = 0; r < 16; ++r) { s[0][r] *= alpha; s[1][r] -= dl; }
            }
#define PACK8(S, B) __builtin_bit_cast(bf16x8, (u32x4){cvt_pk_bf16(S[B], S[B + 1]), cvt_pk_bf16(S[B + 2], S[B + 3]), cvt_pk_bf16(S[B + 4], S[B + 5]), cvt_pk_bf16(S[B + 6], S[B + 7])})
            float lsum = 0.f;
#pragma unroll
            for (int r = 0; r < 16; ++r) lsum += s[0][r];
            bf16x8 pb[4];
            pb[0] = PACK8(s[0], 0); pb[1] = PACK8(s[0], 8);
            __builtin_amdgcn_sched_barrier(0);
            __builtin_amdgcn_s_setprio(1);
#pragma unroll
            for (int c = 0; c < 2; ++c) {
                bf16x8 vf[4];
#pragma unroll
                for (int d = 0; d < 4; ++d) vf[d] = *(const LAS bf16x8*)(Vb + vfo + d * 32 * ATT_VP + c * 32);
#pragma unroll
                for (int d = 0; d < 4; ++d) { o[d] = MFMA32(vf[d], pb[c], o[d]);
                    s[1][(c * 4 + d) * 2] = __builtin_amdgcn_exp2f(s[1][(c * 4 + d) * 2]); s[1][(c * 4 + d) * 2 + 1] = __builtin_amdgcn_exp2f(s[1][(c * 4 + d) * 2 + 1]);
                    __builtin_amdgcn_sched_barrier(0); }
            }
            pb[2] = PACK8(s[1], 0); pb[3] = PACK8(s[1], 8);
            __builtin_amdgcn_sched_barrier(0);
#pragma unroll
            for (int c = 2; c < 4; ++c) {
                bf16x8 vf[4];
#pragma unroll
                for (int d = 0; d < 4; ++d) vf[d] = *(const LAS bf16x8*)(Vb + vfo + d * 32 * ATT_VP + c * 32);
#pragma unroll
                for (int d = 0; d < 4; ++d) { o[d] = MFMA32(vf[d], pb[c], o[d]);
                    lsum += s[1][((c - 2) * 4 + d) * 2] + s[1][((c - 2) * 4 + d) * 2 + 1];
                    __builtin_amdgcn_sched_barrier(0); }
            }
            __builtin_amdgcn_s_setprio(0);
            l_run += lsum;
#undef PACK8
        }
        STORE_LDS((i + 1) & 1);
        __syncthreads();
    }
#undef TILE_OF
#undef LOADG
#undef STORE_LDS
    const float lt = l_run + __shfl_xor(l_run, 32), inv = 1.0f / lt;
#pragma unroll
    for (int d = 0; d < 4; ++d)
#pragma unroll
        for (int r = 0; r < 16; ++r) o[d][r] *= inv;
}

#define XB_TMO      128
#define XB_XCNT(j)  (256  + 64 * (j))
#define XB_XSUB(j)  (1280 + 64 * (j))
#define XB_XGEN(j)  (2304 + 64 * (j))
#define XB_TOP      3328
#define XB_TOPGEN   3392
#define XCD_BAR_WORDS 3456
#define XB_SPIN_CAP (1u << 18)

__device__ __forceinline__ unsigned xb_ld(unsigned* p)              { return __hip_atomic_load(p, __ATOMIC_RELAXED, __HIP_MEMORY_SCOPE_AGENT); }
__device__ __forceinline__ unsigned xb_add(unsigned* p, unsigned v) { return __hip_atomic_fetch_add(p, v, __ATOMIC_RELAXED, __HIP_MEMORY_SCOPE_AGENT); }
__device__ __forceinline__ unsigned xb_xcc_id() { return (unsigned)__builtin_amdgcn_s_getreg((3 << 11) | 20) & 0xFu; }
#define XB_SPIN(cond, bar) do { unsigned _sp = 0; while (cond) { __builtin_amdgcn_s_sleep(1); \
    if ((++_sp & 255u) == 0u) { if (xb_ld(&(bar)[XB_TMO])) break; if (_sp > XB_SPIN_CAP) { atomicAdd(&(bar)[XB_TMO], 1u); break; } } } } while (0)

struct XcdBarrier {
    unsigned* bar; unsigned x;
    volatile LAS unsigned* st;
};

__device__ __forceinline__ XcdBarrier xcd_barrier_post(unsigned* bar, volatile LAS unsigned* st) {
    XcdBarrier b; b.bar = bar; b.x = xb_xcc_id(); b.st = st;
    if (threadIdx.x == 0) (void)xb_add(&bar[XB_XCNT(b.x)], 1u);
    return b;
}
__device__ __forceinline__ void xcd_barrier_complete(unsigned* bar, unsigned x, unsigned& nloc, unsigned& nx) {
    const unsigned G = gridDim.x * gridDim.y * gridDim.z;
    unsigned sum, cnt, mine, sp = 0u;
    for (;;) {
        sum = 0u; cnt = 0u; mine = 0u;
#pragma unroll
        for (unsigned j = 0; j < 16; ++j) { const unsigned c = xb_ld(&bar[XB_XCNT(j)]); sum += c; cnt += (c > 0u) ? 1u : 0u; mine = (j == x) ? c : mine; }
        if (sum == G) break;
        __builtin_amdgcn_s_sleep(1);
        if ((++sp & 255u) == 0u) { if (xb_ld(&bar[XB_TMO])) break; if (sp > XB_SPIN_CAP) { atomicAdd(&bar[XB_TMO], 1u); break; } }
    }
    nloc = mine > 0u ? mine : 1u; nx = cnt > 0u ? cnt : 1u;
}

__device__ __forceinline__ void xcd_barrier(const XcdBarrier& b) {
    asm volatile("s_waitcnt vmcnt(0)" ::: "memory");
    __syncthreads();
    if (threadIdx.x == 0) {
        unsigned* bar = b.bar;
        __builtin_amdgcn_s_waitcnt(0);
        unsigned nloc = b.st[0], nx = b.st[1];
        if (nloc == 0u) { xcd_barrier_complete(bar, b.x, nloc, nx); b.st[0] = nloc; b.st[1] = nx; }
        const unsigned old = xb_add(&bar[XB_XSUB(b.x)], 1u);
        const unsigned gen = old / nloc;
        if (old + 1u == (gen + 1u) * nloc) {
            __builtin_amdgcn_fence(__ATOMIC_RELEASE, "agent");
            asm volatile("s_waitcnt vmcnt(0)" ::: "memory");
            const unsigned og = xb_add(&bar[XB_TOP], 1u);
            const unsigned tg = og / nx;
            if (og + 1u == (tg + 1u) * nx) xb_add(&bar[XB_TOPGEN], 1u);
            else XB_SPIN(xb_ld(&bar[XB_TOPGEN]) == tg, bar);
            __builtin_amdgcn_fence(__ATOMIC_ACQUIRE, "agent");
            xb_add(&bar[XB_XGEN(b.x)], 1u);
            asm volatile("s_waitcnt vmcnt(0)" ::: "memory");
        } else {
            XB_SPIN(xb_ld(&bar[XB_XGEN(b.x)]) == gen, bar);
            __builtin_amdgcn_fence(__ATOMIC_ACQUIRE, "agent");
            asm volatile("s_waitcnt vmcnt(0)" ::: "memory");
        }
    }
    __syncthreads();
}

#ifndef PHASES
#define PHASES 0xFFFF
#endif
#ifndef DUP_MASK
#define DUP_MASK 0
#endif
#define REP(bit) _Pragma("unroll 1") for (int rep_ = 0; rep_ < 1 + ((DUP_MASK >> (bit)) & 1); ++rep_)
struct Args { const float* in[18]; float* out; unsigned char* ws; };

__global__ void __launch_bounds__(512, 2) mega_fwd(Args a) {
    extern __shared__ __attribute__((aligned(16))) unsigned char lds_raw[];
    LAS unsigned char* lds = (LAS unsigned char*)lds_raw;
    cg::grid_group grid = cg::this_grid();
    const int G = gridDim.x, NGW = G * 8;
    volatile LAS unsigned* bar_st = (volatile LAS unsigned*)(lds + LDS_BYTES - 64);
    if (threadIdx.x < 2) bar_st[threadIdx.x] = 0u;
    __syncthreads();
    const XcdBarrier xbar = xcd_barrier_post((unsigned*)(a.ws + WS_BAR), bar_st);
#define SEAM() xcd_barrier(xbar)
    if (a.out == nullptr) grid.sync();
#define PHASE_IDS() int tid_o = threadIdx.x; asm volatile("" : "+v"(tid_o)); const int tid = tid_o, lane = tid & 63, wave = __builtin_amdgcn_readfirstlane(tid >> 6), gw = blockIdx.x * 8 + wave; \
    LAS unsigned* scr = (LAS unsigned*)(lds + wave * 16896); (void)tid; (void)lane; (void)gw; (void)scr;
    unsigned char* ws = a.ws;
    float* SSQ0 = (float*)(ws + WS_SSQ0); float* SSQ1 = (float*)(ws + WS_SSQ1); float* SSQ2 = (float*)(ws + WS_SSQ2); float* SSQ3 = (float*)(ws + WS_SSQ3);
    float* KMEAN = (float*)(ws + WS_KMEAN);
    bf16_t* WGU = (bf16_t*)(ws + WS_WGU); bf16_t* WDN = (bf16_t*)(ws + WS_WDN); bf16_t* WGU1 = (bf16_t*)(ws + WS_WGU1); bf16_t* WDN1 = (bf16_t*)(ws + WS_WDN1); bf16_t* WIN = (bf16_t*)(ws + WS_WIN); bf16_t* WV = (bf16_t*)(ws + WS_WV);
    bf16_t* WPA = (bf16_t*)(ws + WS_WPA); bf16_t* WPB = (bf16_t*)(ws + WS_WPB); bf16_t* WO = (bf16_t*)(ws + WS_WO);
    bf16_t* XB = (bf16_t*)(ws + WS_XB); bf16_t* ACT = (bf16_t*)(ws + WS_ACT); bf16_t* OA = (bf16_t*)(ws + WS_OA); bf16_t* OB = (bf16_t*)(ws + WS_OB);
    bf16_t* PJ = (bf16_t*)(ws + WS_PJ); bf16_t* VT = (bf16_t*)(ws + WS_VT); bf16_t* MG = VT;
    float* STASH = (float*)(ws + WS_ACT + 32 * MiB);
    float* XR = a.out;

    if (PHASES & (1 << 0)) REP(0)
    {
        PHASE_IDS();
        constexpr int NI = 5632 + 1024 + 1024 + 2048 + 512 + 512 + 512 + 512 + 1024 + WGU2_EARLY;
#define P0_DESC(it_, D) do { int r = (it_); const float* W; int K, Nsrc, c0, nc, r0 = 0, mode = 0; bf16_t* WT; const float* g = nullptr; \
            if (r < 5632) { W = a.in[2]; K = 2048; Nsrc = 11264; c0 = 0; nc = 11264; WT = WGU1; g = a.in[1]; mode = 1; } \
            else if ((r -= 5632) < 1024) { W = a.in[5]; K = 2048; Nsrc = 10240; c0 = 0; nc = 2048; WT = WIN; r0 = 0; g = a.in[4]; } \
            else if ((r -= 1024) < 1024) { W = a.in[5]; K = 2048; Nsrc = 10240; c0 = 3072; nc = 2048; WT = WIN; r0 = 2048; g = a.in[4]; } \
            else if ((r -= 1024) < 2048) { W = a.in[5]; K = 2048; Nsrc = 10240; c0 = 6144; nc = 4096; WT = WIN; r0 = 4096; g = a.in[4]; } \
            else if ((r -= 2048) < 512) { W = a.in[5]; K = 2048; Nsrc = 10240; c0 = 2048; nc = 1024; WT = WV; r0 = 0; g = a.in[4]; } \
            else if ((r -= 512) < 512) { W = a.in[5]; K = 2048; Nsrc = 10240; c0 = 5120; nc = 1024; WT = WV; r0 = 1024; g = a.in[4]; } \
            else if ((r -= 512) < 512) { W = a.in[11]; K = 1024; Nsrc = 2048; c0 = 0; nc = 2048; WT = WPA; } \
            else if ((r -= 512) < 512) { W = a.in[12]; K = 1024; Nsrc = 2048; c0 = 0; nc = 2048; WT = WPB; } \
            else if ((r -= 512) < 1024) { W = a.in[13]; K = 2048; Nsrc = 2048; c0 = 0; nc = 2048; WT = WO; } \
            else { r -= 1024; W = a.in[15]; K = 2048; Nsrc = 11264; c0 = 0; nc = 11264; WT = WGU; g = a.in[14]; mode = 1; } \
            D = conv_desc(W, K, Nsrc, c0, nc, WT, r0, g, mode, r); } while (0)
        const bool skip_late = (G == 256);
        for (int it = gw; it < NI - (skip_late ? 7168 : 0); it += NGW) {
            ConvDesc A; P0_DESC(!skip_late ? it : (it < 5632 ? it : it + 7168), A);
            conv_pair(A, A, false, scr, lane);
        }
#undef P0_DESC
        const float* x = a.in[0];
        for (int row = gw; row < M_TOK; row += NGW) {
            const f32x4* xr = (const f32x4*)(x + (size_t)row * DMODEL) + lane; float s = 0.f;
            u32x2* ob = (u32x2*)(XB + (size_t)row * DMODEL) + lane;
            f32x4 xv[8];
#pragma unroll
            for (int j = 0; j < 8; ++j) xv[j] = __builtin_nontemporal_load(xr + 64 * j);
#pragma unroll
            for (int j = 0; j < 8; ++j) { const f32x4 v = xv[j]; s += (v[0] * v[0] + v[1] * v[1]) + (v[2] * v[2] + v[3] * v[3]); u32x2 w; w.x = cvt_pk_bf16(v[0], v[1]); w.y = cvt_pk_bf16(v[2], v[3]); ob[64 * j] = w; }
            s = wave_sum(s);
            if (lane < 32) SSQ0[(size_t)row * 32 + lane] = (lane == 0) ? s : 0.f;
        }
    }
    SEAM();

    if (PHASES & (1 << 1)) REP(1)
    {
    { Gemm g{XB, WGU1, M_TOK, 2 * DFF, DMODEL}; StaticOrder S; S.init(M_TOK, 2 * DFF, G, (int)blockIdx.x); EpiSwiglu E{ACT, DFF, SSQ0};
      gemm_phase<EpiSwiglu, StaticOrder, true, true>(lds, g, S, E); }
    {
        PHASE_IDS();
        const int nwg = (M_TOK / 256) * (2 * DFF / 256), rounds = (nwg + G - 1) / G, rem = nwg - (rounds - 1) * G;
        int first = gw, stride = NGW;
        if (rem < G) { first = ((int)blockIdx.x - rem) * 8 + wave; stride = (G - rem) * 8; if ((int)blockIdx.x < rem) first = 1 << 30; }
#define T1_DESC(it_, D) do { if ((it_) < 2816) D = conv_desc(a.in[3], 5632, 2048, 0, 2048, WDN1, 0, nullptr, 0, (it_)); \
            else if (G != 256) D = conv_desc(a.in[15], 2048, 11264, 0, 11264, WGU, 0, a.in[14], 1, (it_) - 2816 + WGU2_EARLY); \
            else if ((it_) < 2816 + 512) D = conv_desc(a.in[11], 1024, 2048, 0, 2048, WPA, 0, nullptr, 0, (it_) - 2816); \
            else if ((it_) < 2816 + 1024) D = conv_desc(a.in[12], 1024, 2048, 0, 2048, WPB, 0, nullptr, 0, (it_) - 2816 - 512); \
            else if ((it_) < 2816 + 2048) D = conv_desc(a.in[13], 2048, 2048, 0, 2048, WO, 0, nullptr, 0, (it_) - 2816 - 1024); \
            else if ((it_) < 2816 + 4096) D = conv_desc(a.in[5], 2048, 10240, 6144, 4096, WIN, 4096, a.in[4], 0, (it_) - 2816 - 2048); \
            else if ((it_) < 2816 + 5120) D = conv_desc(a.in[5], 2048, 10240, 0, 2048, WIN, 0, a.in[4], 0, (it_) - 2816 - 4096); \
            else if ((it_) < 2816 + 6144) D = conv_desc(a.in[5], 2048, 10240, 3072, 2048, WIN, 2048, a.in[4], 0, (it_) - 2816 - 5120); \
            else if ((it_) < 2816 + 6656) D = conv_desc(a.in[5], 2048, 10240, 2048, 1024, WV, 0, a.in[4], 0, (it_) - 2816 - 6144); \
            else D = conv_desc(a.in[5], 2048, 10240, 5120, 1024, WV, 1024, a.in[4], 0, (it_) - 2816 - 6656); } while (0)
        for (int it = first; it < (G == 256 ? 2816 + TAIL1_EXTRA : 2816 + 5632 - WGU2_EARLY); it += stride) {
            ConvDesc A; T1_DESC(it, A);
            conv_pair(A, A, false, scr, lane);
        }
#undef T1_DESC
        __syncthreads();
    }
    }
    SEAM();
    if ((DUP_MASK >> 17) & 1) { _Pragma("unroll 1") for (int q = 0; q < 20; ++q) SEAM(); }
    if (PHASES & (1 << 2)) REP(2)
    { Gemm g{ACT, WDN1, M_TOK, DMODEL, DFF}; StaticOrder S; S.init(M_TOK, DMODEL, G, (int)blockIdx.x); EpiRes E{a.in[0], XR, XB, SSQ1, 0.5f};
      gemm_phase<EpiRes, StaticOrder, true, true>(lds, g, S, E); }
    SEAM();
    if (PHASES & (1 << 3)) REP(3)
    {
    { Gemm g{XB, WIN, M_TOK, PJ_LD, DMODEL}; StaticOrder S; S.init(M_TOK, PJ_LD, G, (int)blockIdx.x); EpiProj E{PJ, PJ_LD, SSQ1, QA_SCALE, QB_SCALE, KMEAN};
      gemm_phase<EpiProj, StaticOrder, true, true>(lds, g, S, E); }
    { Gemm g{WV, XB, 2048, M_TOK, DMODEL}; StaticOrder S; S.init(2048, M_TOK, G, (int)blockIdx.x); EpiVt E{VT, VT_LD, SSQ1};
      gemm_phase<EpiVt, StaticOrder, true, true>(lds, g, S, E); }
    }
    SEAM();
    if (PHASES & (1 << 5)) REP(5)
    {
        float lam;
        { int l_o = threadIdx.x; asm volatile("" : "+v"(l_o)); const int lane = l_o & 63; const float p1 = wave_sum(a.in[6][lane] * a.in[7][lane]), p2 = wave_sum(a.in[8][lane] * a.in[9][lane]); lam = __uint_as_float(__builtin_amdgcn_readfirstlane(__float_as_uint(expf(p1) - expf(p2) + 0.2f))); }
        unsigned* cnt_u = (unsigned*)(a.ws + WS_BAR) + 3600; unsigned* cnt_c = (unsigned*)(a.ws + WS_BAR) + 3968;
        volatile LAS unsigned* wq = (volatile LAS unsigned*)(lds + LDS_BYTES - 128);
        const int xq = (int)(blockIdx.x & 7);
#ifndef ATT_DYNAMIC
#define ATT_DYNAMIC 0
#endif
#pragma unroll 1
        for (int ustat = blockIdx.x;; ustat += G) {
            int ucode, useq;
            if (ATT_DYNAMIC) {
                __syncthreads();
                if (threadIdx.x == 0) wq[0] = __hip_atomic_fetch_add(cnt_u + 16 * xq, 1u, __ATOMIC_RELAXED, __HIP_MEMORY_SCOPE_AGENT);
                __syncthreads();
                const int useq8 = __builtin_amdgcn_readfirstlane((int)wq[0]);
                if (useq8 >= 64) break;
                ucode = (int)((0x809A1B2CD3E4F567ull >> (4 * (useq8 >> 2))) & 15ull);
                useq = (useq8 & 3) * 8 + xq;
            } else {
                if (G == 256) {
                    const int k = (int)blockIdx.x >> 5, ui = (ustat - (int)blockIdx.x) >> 8;
                    const int nu = (k == 0) ? 1 : (k == 7 ? 3 : 2);
                    if (ui >= nu * (1 + ((DUP_MASK >> 16) & 1))) break;
                    const unsigned codes = (k == 0) ? 0x007u : (k == 1) ? 0x006u : (k == 2) ? 0x015u : (k == 3) ? 0x024u : (k == 4) ? 0x0D3u : (k == 5) ? 0x0BFu : (k == 6) ? 0x0CEu : 0x89Au;
                    ucode = (int)((codes >> (4 * (ui % nu))) & 15u); useq = (int)blockIdx.x & 31;
                } else {
                if (ustat >= 512 * (1 + ((DUP_MASK >> 16) & 1))) break;
                const int us = ustat & 511;
                useq = us & 31; ucode = us < 256 ? (us >> 5) : (8 | (7 - ((us - 256) >> 5)));
                }
            }
            int tid_o = threadIdx.x; asm volatile("" : "+v"(tid_o));
            const int tid = tid_o, lane = tid & 63, r32 = lane & 31, hi = lane >> 5, wave = __builtin_amdgcn_readfirstlane(tid >> 6);
#ifndef TEST_ATT
#define TEST_ATT 3
#endif
            if (ucode < 8) { if (TEST_ATT & 1) {
                const int qblk = ucode & 7, bh = useq & 31, b = bh >> 3, h = bh & 7, q0 = qblk * 256;
                const float sl2 = exp2f(-(float)(h + 1)) * LOG2E;
                const size_t row = (size_t)b * SEQ + q0 + wave * 32 + r32;
                f32x16 o[4];
                f32x4* stash = (f32x4*)(STASH + ((size_t)blockIdx.x * 512 + tid) * 64);
#pragma unroll 1
                for (int mp = 0; mp < 2; ++mp) {
                    flash_pass<64, false>(lds, PJ + row * PJ_LD + h * 128 + mp * 64, PJ + (size_t)b * SEQ * PJ_LD + 1024 + h * 128 + mp * 64, VT + (size_t)(h * 128) * VT_LD + (size_t)b * SEQ, q0, qblk, sl2, 0u, o, tid);
                    if (mp == 0) {
#pragma unroll
                        for (int d = 0; d < 4; ++d)
#pragma unroll
                            for (int g4 = 0; g4 < 4; ++g4) stash[d * 4 + g4] = (f32x4){o[d][4 * g4], o[d][4 * g4 + 1], o[d][4 * g4 + 2], o[d][4 * g4 + 3]}; }
                }
                float ss = 0.f;
#pragma unroll
                for (int d = 0; d < 4; ++d) {
#pragma unroll
                    for (int g4 = 0; g4 < 4; ++g4) { const f32x4 s0 = stash[d * 4 + g4];
#pragma unroll
                        for (int j = 0; j < 4; ++j) { const float v = s0[j] - lam * o[d][4 * g4 + j]; o[d][4 * g4 + j] = v; ss += v * v; } }
                    __builtin_amdgcn_sched_barrier(0); }
                ss += __shfl_xor(ss, 32);
                const float rinv = rsqrtf(ss * (1.0f / 128.0f) + RMS_EPS) * 0.8f;
                bf16_t* op = OA + row * 1024 + h * 128;
#pragma unroll
                for (int d = 0; d < 4; ++d)
#pragma unroll
                    for (int g4 = 0; g4 < 4; ++g4) { const int dd = 32 * d + 8 * g4 + 4 * hi; const f32x4 gs = *(const f32x4*)(a.in[10] + dd);
                        u32x2 w; w.x = cvt_pk_bf16(o[d][4 * g4 + 0] * rinv * gs[0], o[d][4 * g4 + 1] * rinv * gs[1]); w.y = cvt_pk_bf16(o[d][4 * g4 + 2] * rinv * gs[2], o[d][4 * g4 + 3] * rinv * gs[3]);
                        *(u32x2*)(op + dd) = w; }
            } } else if (TEST_ATT & 2) {
                const int qblk = ucode & 7, bh = useq & 31, b = bh >> 3, h = bh & 7, q0 = qblk * 256;
                const float sl2 = exp2f(-(float)(h + 1)) * LOG2E;
                const size_t row = (size_t)b * SEQ + q0 + wave * 32 + r32;
                const bf16_t* qp = PJ + row * PJ_LD + 2048 + h * 128;
                unsigned sel = 0u;
                if (qblk <= 3) sel = (1u << qblk) - 1u;
                else {
                    float qv[64];
#pragma unroll
                    for (int i = 0; i < 8; ++i) { const u32x4 w = *(const u32x4*)(qp + 64 * hi + 8 * i);
                        qv[8 * i + 0] = bf_lo(w.x); qv[8 * i + 1] = bf_hi(w.x); qv[8 * i + 2] = bf_lo(w.y); qv[8 * i + 3] = bf_hi(w.y); qv[8 * i + 4] = bf_lo(w.z); qv[8 * i + 5] = bf_hi(w.z); qv[8 * i + 6] = bf_lo(w.w); qv[8 * i + 7] = bf_hi(w.w); }
                    LAS float* kml = (LAS float*)(lds + 73728);
                    for (int idx = tid; idx < qblk * 128; idx += 512) { const float* kp = KMEAN + (size_t)(b * 8 + (idx >> 7)) * 2048 + h * 128 + (idx & 127); kml[idx] = kp[0] + kp[1024]; }
                    __syncthreads();
                    float gs[7];
#pragma unroll
                    for (int j = 0; j < 7; ++j) { gs[j] = 0.f;
                        if (j < qblk) { const LAS f32x4* km = (const LAS f32x4*)(kml + j * 128 + 64 * hi); float acc = 0.f;
#pragma unroll
                            for (int i = 0; i < 16; ++i) { const f32x4 k4 = km[i]; acc += qv[4 * i] * k4[0] + qv[4 * i + 1] * k4[1] + qv[4 * i + 2] * k4[2] + qv[4 * i + 3] * k4[3]; }
                            gs[j] = acc + __shfl_xor(acc, 32); }
                        __builtin_amdgcn_sched_barrier(0); }
#pragma unroll
                    for (int t = 0; t < 3; ++t) { float best = -INFINITY; int bi = 0;
#pragma unroll
                        for (int j = 0; j < 7; ++j) { if (j < qblk && !((sel >> j) & 1u) && gs[j] > best) { best = gs[j]; bi = j; } }
                        sel |= 1u << bi; }
                }
                f32x16 o[4];
                flash_pass<128, true>(lds, qp, PJ + (size_t)b * SEQ * PJ_LD + 3072 + h * 128, VT + (size_t)(1024 + h * 128) * VT_LD + (size_t)b * SEQ, q0, qblk, sl2, sel, o, tid);
                bf16_t* op = OB + row * 1024 + h * 128;
#pragma unroll
                for (int d = 0; d < 4; ++d)
#pragma unroll
                    for (int g4 = 0; g4 < 4; ++g4) { const int dd = 32 * d + 8 * g4 + 4 * hi;
                        u32x2 w; w.x = cvt_pk_bf16(o[d][4 * g4 + 0], o[d][4 * g4 + 1]); w.y = cvt_pk_bf16(o[d][4 * g4 + 2], o[d][4 * g4 + 3]);
                        *(u32x2*)(op + dd) = w; }
            }
        }
        if (G == 256) {
            PHASE_IDS();
            unsigned* cnt_f = (unsigned*)(a.ws + WS_BAR) + 7040;
            volatile LAS unsigned* wq2 = (volatile LAS unsigned*)(lds + LDS_BYTES - 128);
#pragma unroll 1
            for (;;) {
                __syncthreads();
                if (threadIdx.x == 0) wq2[0] = __hip_atomic_fetch_add(cnt_f, 1u, __ATOMIC_RELAXED, __HIP_MEMORY_SCOPE_AGENT);
                __syncthreads();
                const int it = WGU2_EARLY + __builtin_amdgcn_readfirstlane((int)wq2[0]) * 8 + wave;
                if (it - wave >= 5632) break;
                const ConvDesc A = conv_desc(a.in[15], 2048, 11264, 0, 11264, WGU, 0, a.in[14], 1, it);
                conv_pair(A, A, false, scr, lane);
            }
            __syncthreads();
        }
        if (ATT_DYNAMIC) {
            PHASE_IDS();
#pragma unroll 1
            for (;;) {
                unsigned itv = 0u; if (lane == 0) itv = __hip_atomic_fetch_add(cnt_c, 1u, __ATOMIC_RELAXED, __HIP_MEMORY_SCOPE_AGENT);
                const int it = __builtin_amdgcn_readfirstlane((int)itv);
                if (it >= 5632) break;
                const ConvDesc A = conv_desc(a.in[15], 2048, 11264, 0, 11264, WGU, 0, a.in[14], 1, it);
                conv_pair(A, A, false, scr, lane);
            }
        }
    }
    SEAM();
    if (PHASES & (1 << 6)) REP(6)
    {
    { Gemm g{OA, WPA, M_TOK, DMODEL, 1024}; StaticOrder S; S.init(M_TOK, DMODEL, G, (int)blockIdx.x); EpiGate<true> E{MG, PJ + 4096, PJ_LD};
      gemm_phase<EpiGate<true>, StaticOrder, true, true>(lds, g, S, E); }
    { Gemm g{OB, WPB, M_TOK, DMODEL, 1024}; StaticOrder S; S.init(M_TOK, DMODEL, G, (int)blockIdx.x); EpiGate<false> E{MG, PJ + 6144, PJ_LD};
      gemm_phase<EpiGate<false>, StaticOrder, true, true>(lds, g, S, E); }
    }
    SEAM();
    if (PHASES & (1 << 7)) REP(7)
    { Gemm g{MG, WO, M_TOK, DMODEL, DMODEL}; StaticOrder S; S.init(M_TOK, DMODEL, G, (int)blockIdx.x); EpiRes E{XR, XR, XB, SSQ2, 1.0f};
      gemm_phase<EpiRes, StaticOrder, true, true>(lds, g, S, E); }
    SEAM();
    if (PHASES & (1 << 8)) REP(8)
    {
    { Gemm g{XB, WGU, M_TOK, 2 * DFF, DMODEL}; StaticOrder S; S.init(M_TOK, 2 * DFF, G, (int)blockIdx.x); EpiSwiglu E{ACT, DFF, SSQ2};
      gemm_phase<EpiSwiglu, StaticOrder, true, true>(lds, g, S, E); }
    {
        PHASE_IDS();
        const int nwg = (M_TOK / 256) * (2 * DFF / 256), rounds = (nwg + G - 1) / G, rem = nwg - (rounds - 1) * G;
        int first = gw, stride = NGW;
        if (rem < G) { first = ((int)blockIdx.x - rem) * 8 + wave; stride = (G - rem) * 8; if ((int)blockIdx.x < rem) first = 1 << 30; }
        for (int it = first; it < 2816; it += stride) {
            const ConvDesc A = conv_desc(a.in[16], 5632, 2048, 0, 2048, WDN, 0, nullptr, 0, it);
            conv_pair(A, A, false, scr, lane);
        }
        __syncthreads();
    }
    }
    SEAM();
    if (G == 256) {
        Gemm g{ACT, WDN, M_TOK, DMODEL, DFF}; StaticOrder S; S.init(M_TOK, DMODEL, G, (int)blockIdx.x);
        EpiResNorm E{XR, XR, a.in[17], 0.5f, (float*)(ws + WS_XS), (unsigned*)(ws + WS_BAR) + 4096};
        gemm_phase<EpiResNorm, StaticOrder, false, true>(lds, g, S, E);
    } else {
    { Gemm g{ACT, WDN, M_TOK, DMODEL, DFF}; StaticOrder S; S.init(M_TOK, DMODEL, G, (int)blockIdx.x); EpiRes E{XR, XR, nullptr, SSQ3, 0.5f};
      gemm_phase<EpiRes, StaticOrder, true, true>(lds, g, S, E); }
    SEAM();
    {
        PHASE_IDS();
        const f32x4* gf = (const f32x4*)a.in[17] + lane;
        for (int row = gw; row < M_TOK; row += NGW) {
            const float rs = row_rstd(SSQ3, row);
            f32x4* xr = (f32x4*)(XR + (size_t)row * DMODEL) + lane;
            f32x4 xv[8];
#pragma unroll
            for (int j = 0; j < 8; ++j) xv[j] = xr[64 * j];
#pragma unroll
            for (int j = 0; j < 8; ++j) xr[64 * j] = xv[j] * rs * gf[64 * j];
        }
    }
    }
}

extern "C" void kernel_launch(void* const* d_in, const int* in_sizes, int n_in, void* d_out, int out_size, void* d_ws, size_t ws_size, hipStream_t stream) {
    static int grid_blocks = 0;
    if (grid_blocks == 0) {
        if (n_in != 18 || out_size != M_TOK * DMODEL || ws_size < WS_END) { fprintf(stderr, "kernel_launch: unexpected shapes (n_in %d out %d ws %zu)\n", n_in, out_size, ws_size); grid_blocks = -1; return; }
        int dev = 0, cus = 0, per_cu = 0;
        (void)hipGetDevice(&dev);
        (void)hipDeviceGetAttribute(&cus, hipDeviceAttributeMultiprocessorCount, dev);
        (void)hipFuncSetAttribute((const void*)mega_fwd, hipFuncAttributeMaxDynamicSharedMemorySize, LDS_BYTES);
        (void)hipOccupancyMaxActiveBlocksPerMultiprocessor(&per_cu, (const void*)mega_fwd, 512, LDS_BYTES);
        if (per_cu < 1) { fprintf(stderr, "kernel_launch: occupancy query says %d blocks per CU\n", per_cu); per_cu = 1; }
        grid_blocks = cus < 256 ? cus : 256;
        (void)hipGetLastError();
    }
    if (grid_blocks < 0) return;
    (void)hipMemsetAsync((unsigned char*)d_ws + WS_BAR, 0, BAR_BYTES, stream);
    Args a{};
    for (int i = 0; i < 18; ++i) a.in[i] = (const float*)d_in[i];
    a.out = (float*)d_out; a.ws = (unsigned char*)d_ws;
    void* args[] = {&a};
    hipError_t e = hipLaunchCooperativeKernel((const void*)mega_fwd, dim3(grid_blocks), dim3(512), args, LDS_BYTES, stream);
    if (e != hipSuccess) fprintf(stderr, "cooperative launch failed: %s (grid %d)\n", hipGetErrorString(e), grid_blocks);
}
```

```cpp
#include <hip/hip_runtime.h>
#include <hip/hip_cooperative_groups.h>
#include <cstdio>
#include <cstdint>
#include <cmath>
namespace cg = cooperative_groups;
namespace pg8 {
#define PG8_LAS __attribute__((address_space(3)))
typedef unsigned short bf16_t;
typedef short bf16x8 __attribute__((ext_vector_type(8)));
typedef float f32x4 __attribute__((ext_vector_type(4)));
typedef unsigned u32x4 __attribute__((ext_vector_type(4)));
constexpr int BM = 256, BK = 64, HALF = 128, HTB = HALF * BK * 2  , STAGE_BYTES = 8 * HTB, NXCD = 8, WGM = 8;

__host__ __device__ __forceinline__ int lds_byte(int r, int c) { const int st = (r >> 4) * 2 + (c >> 5), rr = r & 15, cc = c & 31, ob = rr * 64 + cc * 2; return st * 1024 + (ob ^ (((ob >> 9) & 1) << 5)); }
__host__ __device__ __forceinline__ void stage_rc(int b, int& R, int& C) { const int st = b / 1024, sb = b % 1024, swz = sb ^ (((sb >> 9) & 1) << 5); R = (st >> 1) * 16 + swz / 64; C = (st & 1) * 32 + (swz % 64) / 2; }
__host__ __device__ __forceinline__ int perm32(int rho) { const int n = rho >> 4, i = rho & 15; return 8 * (i >> 2) + 4 * n + (i & 3); }

struct Unit { int pm, pn; };
struct Gemm { const bf16_t* A; const bf16_t* Bt; int M, N, K; };

struct StaticOrder {
    int nM, nN, nwg, G, c;
    __host__ __device__ void init(int M, int N, int G_, int c_) { nM = M / BM; nN = N / BM; nwg = nM * nN; G = G_; c = c_; }
    __host__ __device__ bool next(int i, Unit& u) const {
        const long L = (long)i * G + c; if (L >= nwg) return false;
        int wgid = (int)L; { const int q = nwg / NXCD, r = nwg % NXCD, xcd = wgid % NXCD, off = wgid / NXCD; wgid = (xcd < r ? xcd * (q + 1) : r * (q + 1) + (xcd - r) * q) + off; }
        const int nig = WGM * nN, gid = wgid / nig, fm = gid * WGM, gsz = (nM - fm) < WGM ? (nM - fm) : WGM;
        u.pm = fm + ((wgid % nig) % gsz); u.pn = (wgid % nig) / gsz; return true;
    }
    __device__ __forceinline__ void a_ready(const Unit&) const {}
    __device__ __forceinline__ void done(const Unit&) const {}
};


typedef float f32x2 __attribute__((ext_vector_type(2)));
typedef unsigned u32x2 __attribute__((ext_vector_type(2)));
typedef __bf16 bf16x2_t __attribute__((ext_vector_type(2)));
__device__ __forceinline__ unsigned cvt_pk_bf16(float lo, float hi) { f32x2 v = {lo, hi}; bf16x2_t b = __builtin_convertvector(v, bf16x2_t); return __builtin_bit_cast(unsigned, b); }
__device__ __forceinline__ float bf_lo(unsigned u) { return __uint_as_float(u << 16); }
__device__ __forceinline__ float bf_hi(unsigned u) { return __uint_as_float(u & 0xffff0000u); }
constexpr int DMODEL = 2048;
constexpr float RMS_EPS = 1e-6f;
constexpr float LOG2E = 1.4426950408889634f;
__device__ __forceinline__ float row_rstd(const float* ssq, int row) {
    const f32x4* p = (const f32x4*)(ssq + (size_t)row * 32);
    float s = 0.f;
#pragma unroll
    for (int i = 0; i < 8; ++i) { const f32x4 v = p[i]; s += (v[0] + v[1]) + (v[2] + v[3]); }
    return __builtin_amdgcn_rsqf(s * (1.0f / DMODEL) + RMS_EPS);
}
__device__ __forceinline__ void rows_rstd(const float* ssq, int row0, int fq, float scale, float (&rs)[2][4]) {
    f32x4 pa[2][4], pb[2][4];
#pragma unroll
    for (int ai = 0; ai < 2; ++ai)
#pragma unroll
        for (int m = 0; m < 4; ++m) { const f32x4* p = (const f32x4*)(ssq + (size_t)(row0 + ai * HALF + m * 16) * 32 + 8 * fq); pa[ai][m] = p[0]; pb[ai][m] = p[1]; }
#pragma unroll
    for (int ai = 0; ai < 2; ++ai)
#pragma unroll
        for (int m = 0; m < 4; ++m) { const f32x4 a = pa[ai][m], c = pb[ai][m]; float s = ((a[0] + a[1]) + (a[2] + a[3])) + ((c[0] + c[1]) + (c[2] + c[3]));
            s += __shfl_xor(s, 16); s += __shfl_xor(s, 32); rs[ai][m] = __builtin_amdgcn_rsqf(s * (1.0f / DMODEL) + RMS_EPS) * scale; }
}
__device__ __forceinline__ float silu_f(float x) { return x * __builtin_amdgcn_rcpf(1.0f + __builtin_amdgcn_exp2f(-x * LOG2E)); }
__device__ __forceinline__ float sigmoid_f(float x) { return __builtin_amdgcn_rcpf(1.0f + __builtin_amdgcn_exp2f(-x * LOG2E)); }

struct EpiSwiglu {
    static constexpr bool PERM = true, AFTER_DRAIN = false;
    bf16_t* O; int ldo; const float* ssq;
    __device__ __forceinline__ void operator()(const f32x4 (&acc)[2][2][4][2], const Unit& u, int wr, int wc, int fr, int fq) const {
        const int row0 = u.pm * BM + wr * 64 + fr, col0 = u.pn * HALF + wc * 32 + 8 * fq;
        float rs[2][4];
        rows_rstd(ssq, row0, fq, 1.0f, rs);
#pragma unroll
        for (int ai = 0; ai < 2; ++ai)
#pragma unroll
            for (int m = 0; m < 4; ++m) { const int row = row0 + ai * HALF + m * 16; const float r = rs[ai][m];
                const f32x4 g0 = acc[ai][0][m][0] * r, g1 = acc[ai][0][m][1] * r, u0 = acc[ai][1][m][0] * r, u1 = acc[ai][1][m][1] * r;
                u32x4 w;
                w.x = cvt_pk_bf16(silu_f(g0[0]) * u0[0], silu_f(g0[1]) * u0[1]); w.y = cvt_pk_bf16(silu_f(g0[2]) * u0[2], silu_f(g0[3]) * u0[3]);
                w.z = cvt_pk_bf16(silu_f(g1[0]) * u1[0], silu_f(g1[1]) * u1[1]); w.w = cvt_pk_bf16(silu_f(g1[2]) * u1[2], silu_f(g1[3]) * u1[3]);
                *(u32x4*)(O + (size_t)row * ldo + col0) = w; }
    }
};
struct EpiRes {
    static constexpr bool PERM = false, AFTER_DRAIN = false;
    const float* base; float* out; bf16_t* outb; float* ssq_out; float alpha;
    __device__ __forceinline__ void operator()(const f32x4 (&acc)[2][2][4][2], const Unit& u, int wr, int wc, int fr, int fq) const {
        const int row0 = u.pm * BM + wr * 64 + fr, col0 = u.pn * BM + wc * 32 + 4 * fq;
#pragma unroll
        for (int ai = 0; ai < 2; ++ai) {
            f32x4 bs[4][2][2];
#pragma unroll
            for (int m = 0; m < 4; ++m)
#pragma unroll
                for (int bj = 0; bj < 2; ++bj)
#pragma unroll
                    for (int n = 0; n < 2; ++n) bs[m][bj][n] = *(const f32x4*)(base + (size_t)(row0 + ai * HALF + m * 16) * DMODEL + col0 + bj * HALF + n * 16);
#pragma unroll
            for (int m = 0; m < 4; ++m) { const int row = row0 + ai * HALF + m * 16; const size_t off = (size_t)row * DMODEL + col0; float sq = 0.f;
#pragma unroll
                for (int bj = 0; bj < 2; ++bj)
#pragma unroll
                    for (int n = 0; n < 2; ++n) { const size_t o2 = off + bj * HALF + n * 16; const f32x4 o = bs[m][bj][n] + acc[ai][bj][m][n] * alpha;
                        *(f32x4*)(out + o2) = o; sq += (o[0] * o[0] + o[1] * o[1]) + (o[2] * o[2] + o[3] * o[3]);
                        if (outb) { u32x2 w; w.x = cvt_pk_bf16(o[0], o[1]); w.y = cvt_pk_bf16(o[2], o[3]); *(u32x2*)(outb + o2) = w; } }
                sq += __shfl_xor(sq, 16); sq += __shfl_xor(sq, 32);
                if (fq == 0) ssq_out[(size_t)row * 32 + u.pn * 4 + wc] = sq; }
        }
    }
};
struct EpiProj {
    static constexpr bool PERM = true, AFTER_DRAIN = false;
    bf16_t* O; int ldo; const float* ssq; float qa_scale, qb_scale; float* kpart;
    __device__ __forceinline__ void operator()(const f32x4 (&acc)[2][2][4][2], const Unit& u, int wr, int wc, int fr, int fq) const {
        const int row0 = u.pm * BM + wr * 64 + fr, col0 = u.pn * BM + wc * 32 + 8 * fq;
        const bool sig = u.pn >= 16; const float sc = u.pn < 4 ? qa_scale : ((u.pn >= 8 && u.pn < 12) ? qb_scale : 1.0f);
        float rs[2][4];
        rows_rstd(ssq, row0, fq, sc, rs);
#pragma unroll
        for (int ai = 0; ai < 2; ++ai)
#pragma unroll
            for (int m = 0; m < 4; ++m) { const int row = row0 + ai * HALF + m * 16; const float r = rs[ai][m];
#pragma unroll
                for (int bj = 0; bj < 2; ++bj) { f32x4 v0 = acc[ai][bj][m][0] * r, v1 = acc[ai][bj][m][1] * r;
                    if (sig) {
#pragma unroll
                        for (int j = 0; j < 4; ++j) { v0[j] = sigmoid_f(v0[j]); v1[j] = sigmoid_f(v1[j]); } }
                    u32x4 w; w.x = cvt_pk_bf16(v0[0], v0[1]); w.y = cvt_pk_bf16(v0[2], v0[3]); w.z = cvt_pk_bf16(v1[0], v1[1]); w.w = cvt_pk_bf16(v1[2], v1[3]);
                    *(u32x4*)(O + (size_t)row * ldo + col0 + bj * HALF) = w; } }
        if (u.pn >= 12 && u.pn < 16) {
#pragma unroll
            for (int bj = 0; bj < 2; ++bj) { f32x4 s0 = {0.f, 0.f, 0.f, 0.f}, s1 = {0.f, 0.f, 0.f, 0.f};
#pragma unroll
                for (int ai = 0; ai < 2; ++ai)
#pragma unroll
                    for (int m = 0; m < 4; ++m) { s0 += acc[ai][bj][m][0] * rs[ai][m]; s1 += acc[ai][bj][m][1] * rs[ai][m]; }
#pragma unroll
                for (int j = 0; j < 4; ++j) {
#pragma unroll
                    for (int o = 1; o < 16; o <<= 1) { s0[j] += __shfl_xor(s0[j], o); s1[j] += __shfl_xor(s1[j], o); } }
                if (fr == 0) { float* kp = kpart + ((size_t)u.pm * 2 + wr) * 1024 + (col0 - 3072) + bj * HALF; *(f32x4*)kp = s0; *(f32x4*)(kp + 4) = s1; } }
        }
    }
};
struct EpiVt {
    static constexpr bool PERM = true, AFTER_DRAIN = false;
    bf16_t* O; int ldo; const float* ssq;
    __device__ __forceinline__ void operator()(const f32x4 (&acc)[2][2][4][2], const Unit& u, int wr, int wc, int fr, int fq) const {
        const int row0 = u.pm * BM + wr * 64 + fr, col0 = u.pn * BM + wc * 32 + 8 * fq;
        f32x4 rs[2][2];
        {
            const float mine = row_rstd(ssq, u.pn * BM + (fr >> 3) * HALF + wc * 32 + 8 * fq + (fr & 7));
            const int lbase = fq * 16;
#pragma unroll
            for (int bj = 0; bj < 2; ++bj)
#pragma unroll
                for (int n = 0; n < 2; ++n)
#pragma unroll
                    for (int j = 0; j < 4; ++j) rs[bj][n][j] = __shfl(mine, lbase + bj * 8 + n * 4 + j);
        }
#pragma unroll
        for (int ai = 0; ai < 2; ++ai)
#pragma unroll
            for (int m = 0; m < 4; ++m) { const int row = row0 + ai * HALF + m * 16;
#pragma unroll
                for (int bj = 0; bj < 2; ++bj) { const f32x4 v0 = acc[ai][bj][m][0] * rs[bj][0], v1 = acc[ai][bj][m][1] * rs[bj][1];
                    u32x4 w; w.x = cvt_pk_bf16(v0[0], v0[1]); w.y = cvt_pk_bf16(v0[2], v0[3]); w.z = cvt_pk_bf16(v1[0], v1[1]); w.w = cvt_pk_bf16(v1[2], v1[3]);
                    *(u32x4*)(O + (size_t)row * ldo + col0 + bj * HALF) = w; } }
    }
};
template <bool FIRST> struct EpiGate {
    static constexpr bool PERM = true, AFTER_DRAIN = false;
    bf16_t* T; const bf16_t* sig; int ldsig;
    __device__ __forceinline__ void operator()(const f32x4 (&acc)[2][2][4][2], const Unit& u, int wr, int wc, int fr, int fq) const {
        const int row0 = u.pm * BM + wr * 64 + fr, col0 = u.pn * BM + wc * 32 + 8 * fq;
#pragma unroll
        for (int ai = 0; ai < 2; ++ai) {
            u32x4 sg[4][2], tt[4][2];
#pragma unroll
            for (int m = 0; m < 4; ++m)
#pragma unroll
                for (int bj = 0; bj < 2; ++bj) { const int row = row0 + ai * HALF + m * 16, col = col0 + bj * HALF;
                    sg[m][bj] = *(const u32x4*)(sig + (size_t)row * ldsig + col);
                    if (!FIRST) tt[m][bj] = *(const u32x4*)(T + (size_t)row * DMODEL + col); }
#pragma unroll
            for (int m = 0; m < 4; ++m) { const int row = row0 + ai * HALF + m * 16;
#pragma unroll
                for (int bj = 0; bj < 2; ++bj) { const int col = col0 + bj * HALF;
                    const u32x4 s = sg[m][bj];
                    const f32x4 a0 = acc[ai][bj][m][0], a1 = acc[ai][bj][m][1];
                    float v[8];
                    v[0] = bf_lo(s.x) * a0[0]; v[1] = bf_hi(s.x) * a0[1]; v[2] = bf_lo(s.y) * a0[2]; v[3] = bf_hi(s.y) * a0[3];
                    v[4] = bf_lo(s.z) * a1[0]; v[5] = bf_hi(s.z) * a1[1]; v[6] = bf_lo(s.w) * a1[2]; v[7] = bf_hi(s.w) * a1[3];
                    bf16_t* tp = T + (size_t)row * DMODEL + col;
                    if (!FIRST) { const u32x4 t = tt[m][bj];
                        v[0] += bf_lo(t.x); v[1] += bf_hi(t.x); v[2] += bf_lo(t.y); v[3] += bf_hi(t.y); v[4] += bf_lo(t.z); v[5] += bf_hi(t.z); v[6] += bf_lo(t.w); v[7] += bf_hi(t.w); }
                    u32x4 w; w.x = cvt_pk_bf16(v[0], v[1]); w.y = cvt_pk_bf16(v[2], v[3]); w.z = cvt_pk_bf16(v[4], v[5]); w.w = cvt_pk_bf16(v[6], v[7]);
                    *(u32x4*)tp = w; } }
        }
    }
};

struct EpiResNorm {
    static constexpr bool PERM = false, AFTER_DRAIN = true;
    const float* base; float* out; const float* gain; float alpha; float* xs; unsigned* cnt;
    __device__ __forceinline__ void operator()(const f32x4 (&)[2][2][4][2], const Unit&, int, int, int, int) const {}
    __device__ __forceinline__ void fused(f32x4 (&acc)[2][2][4][2], const Unit& u, int wr, int wc, int fr, int fq, PG8_LAS unsigned char* lds, int wid, int lane) const {
        PG8_LAS float* P = (PG8_LAS float*)lds;
        PG8_LAS float* S = (PG8_LAS float*)(lds + 8192);
        const int row0 = u.pm * BM + wr * 64 + fr, col0 = u.pn * BM + wc * 32 + 4 * fq;
#pragma unroll
        for (int ai = 0; ai < 2; ++ai) {
            f32x4 bs[4][2][2];
#pragma unroll
            for (int m = 0; m < 4; ++m)
#pragma unroll
                for (int bj = 0; bj < 2; ++bj)
#pragma unroll
                    for (int n = 0; n < 2; ++n) bs[m][bj][n] = *(const f32x4*)(base + (size_t)(row0 + ai * HALF + m * 16) * DMODEL + col0 + bj * HALF + n * 16);
#pragma unroll
            for (int m = 0; m < 4; ++m) { float sq = 0.f;
#pragma unroll
                for (int bj = 0; bj < 2; ++bj)
#pragma unroll
                    for (int n = 0; n < 2; ++n) { const f32x4 o = bs[m][bj][n] + acc[ai][bj][m][n] * alpha; acc[ai][bj][m][n] = o; sq += (o[0] * o[0] + o[1] * o[1]) + (o[2] * o[2] + o[3] * o[3]); }
                sq += __shfl_xor(sq, 16); sq += __shfl_xor(sq, 32);
                if (fq == 0) P[(ai * HALF + wr * 64 + m * 16 + fr) * 4 + wc] = sq; }
        }
        asm volatile("s_waitcnt lgkmcnt(0)" ::: "memory"); __builtin_amdgcn_s_barrier(); asm volatile("" ::: "memory");
        const int row = wid * 32 + (lane & 31);
        if (lane < 32) { const float t = (P[row * 4 + 0] + P[row * 4 + 1]) + (P[row * 4 + 2] + P[row * 4 + 3]);
            __hip_atomic_store(xs + (size_t)(u.pm * BM + row) * 8 + u.pn, t, __ATOMIC_RELAXED, __HIP_MEMORY_SCOPE_AGENT); }
        asm volatile("s_waitcnt vmcnt(0)" ::: "memory");
        if (lane == 0) __hip_atomic_fetch_add(cnt + 64 * u.pm, 1u, __ATOMIC_RELAXED, __HIP_MEMORY_SCOPE_AGENT);
        if (wid == 0) {
            for (unsigned sp = 0; sp < (1u << 22); ++sp) {
                if ((unsigned)__builtin_amdgcn_readfirstlane(__hip_atomic_load(cnt + 64 * u.pm, __ATOMIC_RELAXED, __HIP_MEMORY_SCOPE_AGENT)) >= 64u) break;
                __builtin_amdgcn_s_sleep(2);
            }
            __builtin_amdgcn_fence(__ATOMIC_ACQUIRE, "agent");
        }
        asm volatile("s_waitcnt vmcnt(0) lgkmcnt(0)" ::: "memory"); __builtin_amdgcn_s_barrier(); asm volatile("" ::: "memory");
        if (lane < 32) { const float* sl = xs + (size_t)(u.pm * BM + row) * 8; float t[8];
#pragma unroll
            for (int i = 0; i < 8; ++i) t[i] = __hip_atomic_load(sl + i, __ATOMIC_RELAXED, __HIP_MEMORY_SCOPE_AGENT);
            const float tot = ((t[0] + t[1]) + (t[2] + t[3])) + ((t[4] + t[5]) + (t[6] + t[7]));
            S[row] = __builtin_amdgcn_rsqf(tot * (1.0f / DMODEL) + RMS_EPS); }
        asm volatile("s_waitcnt lgkmcnt(0)" ::: "memory"); __builtin_amdgcn_s_barrier(); asm volatile("" ::: "memory");
        f32x4 gv[2][2];
#pragma unroll
        for (int bj = 0; bj < 2; ++bj)
#pragma unroll
            for (int n = 0; n < 2; ++n) gv[bj][n] = *(const f32x4*)(gain + col0 + bj * HALF + n * 16);
#pragma unroll
        for (int ai = 0; ai < 2; ++ai)
#pragma unroll
            for (int m = 0; m < 4; ++m) { const int rl = ai * HALF + wr * 64 + m * 16 + fr; const float rs = S[rl]; const size_t off = (size_t)(u.pm * BM + rl) * DMODEL + col0;
#pragma unroll
                for (int bj = 0; bj < 2; ++bj)
#pragma unroll
                    for (int n = 0; n < 2; ++n) *(f32x4*)(out + off + bj * HALF + n * 16) = acc[ai][bj][m][n] * rs * gv[bj][n]; }
    }
};

template <class Epi, class Sched, bool ALIGN_EPI = false, bool SP2 = false>
__device__ __forceinline__ void gemm_phase(PG8_LAS unsigned char* lds, const Gemm g, const Sched& S, const Epi& E) {
    int tid_o = threadIdx.x; asm volatile("" : "+v"(tid_o));
    const int tid = tid_o, wid = __builtin_amdgcn_readfirstlane(tid >> 6), lane = tid & 63, wr = wid >> 2, wc = wid & 3, fr = lane & 15, fq = lane >> 4;
    const int K = g.K, nt = K / BK;
    unsigned voffA[2], voffB[2];
#pragma unroll
    for (int i = 0; i < 2; ++i) { int R, C; stage_rc(tid * 16 + i * 8192, R, C); const int Rb = Epi::PERM ? ((R & ~31) + perm32(R & 31)) : R;
        voffA[i] = (unsigned)(R * K + C) * 2u; voffB[i] = (unsigned)(Rb * K + C) * 2u; }
    const size_t kstep = (size_t)(BK * 2);
    const size_t hstep = (size_t)HALF * K * 2;
    const size_t tstep = 2 * hstep;
    const unsigned ldsw = (unsigned)wid * 1024u;
    const int aoff = lds_byte(wr * 64 + fr, fq * 8), boff = lds_byte(wc * 32 + fr, fq * 8);
#define PG8_SA(b, h) (((b) * 2 + (h)) * HTB)
#define PG8_SB(b, h) ((4 + (b) * 2 + (h)) * HTB)
#define PG8_STAGE(bufoff, gbase, voff) do { _Pragma("unroll") for (int _i = 0; _i < 2; ++_i) \
        __builtin_amdgcn_global_load_lds((const unsigned*)((const char*)(gbase) + (voff)[_i]), (PG8_LAS unsigned*)(lds + (bufoff) + ldsw + _i * 8192), 16, 0, 0); } while (0)
#define PG8_LDA(dst, b, h) do { _Pragma("unroll") for (int m = 0; m < 4; ++m) _Pragma("unroll") for (int k = 0; k < 2; ++k) dst[m][k] = *(const PG8_LAS bf16x8*)(lds + PG8_SA(b, h) + aoff + m * 2048 + k * 1024); } while (0)
#define PG8_LDB(dst, b, h) do { _Pragma("unroll") for (int n = 0; n < 2; ++n) _Pragma("unroll") for (int k = 0; k < 2; ++k) dst[n][k] = *(const PG8_LAS bf16x8*)(lds + PG8_SB(b, h) + boff + n * 2048 + k * 1024); } while (0)
#define PG8_MMA(ai, bj, At, Bt) do { __builtin_amdgcn_s_setprio(1); _Pragma("unroll") for (int m = 0; m < 4; ++m) _Pragma("unroll") for (int n = 0; n < 2; ++n) _Pragma("unroll") for (int k = 0; k < 2; ++k) \
        acc[ai][bj][m][n] = __builtin_amdgcn_mfma_f32_16x16x32_bf16(Bt[n][k], At[m][k], acc[ai][bj][m][n], 0, 0, 0); __builtin_amdgcn_s_setprio(0); } while (0)
#define PG8_WAIT_V(n) asm volatile("s_waitcnt vmcnt(" #n ")" ::: "memory")
#define PG8_WAIT_L(n) asm volatile("s_waitcnt lgkmcnt(" #n ")" ::: "memory")
#define PG8_BAR __builtin_amdgcn_s_barrier()
#define PG8_SCHED __builtin_amdgcn_sched_barrier(0)
    Unit cur, nxt; int ui = 0;
    if (!S.next(0, cur)) return;
    f32x4 acc[2][2][4][2];
#pragma unroll
    for (int a = 0; a < 2; ++a)
#pragma unroll
        for (int b = 0; b < 2; ++b)
#pragma unroll
            for (int m = 0; m < 4; ++m)
#pragma unroll
                for (int n = 0; n < 2; ++n) acc[a][b][m][n] = (f32x4){0.f, 0.f, 0.f, 0.f};
    bf16x8 At[4][2], B0[2][2], B1[2][2];
    const char* cA = (const char*)g.A + (size_t)cur.pm * tstep; const char* cB = (const char*)g.Bt + (size_t)cur.pn * tstep;
    S.a_ready(cur);
    if constexpr (SP2) {
        PG8_STAGE(PG8_SB(0, 0), cB, voffB); PG8_STAGE(PG8_SB(0, 1), cB + hstep, voffB); PG8_STAGE(PG8_SA(0, 0), cA, voffA); PG8_STAGE(PG8_SA(0, 1), cA + hstep, voffA);
        if (wr == 1) PG8_BAR;
        PG8_WAIT_V(2); PG8_BAR;
        PG8_STAGE(PG8_SB(1, 0), cB + kstep, voffB); PG8_STAGE(PG8_SA(1, 0), cA + kstep, voffA); PG8_STAGE(PG8_SB(1, 1), cB + hstep + kstep, voffB);
        PG8_WAIT_V(6); PG8_BAR;
    } else {
        PG8_STAGE(PG8_SB(0, 0), cB, voffB); PG8_STAGE(PG8_SA(0, 0), cA, voffA); PG8_STAGE(PG8_SB(0, 1), cB + hstep, voffB); PG8_STAGE(PG8_SA(0, 1), cA + hstep, voffA);
        if (wr == 1) PG8_BAR;
        PG8_WAIT_V(4); PG8_BAR;
        PG8_STAGE(PG8_SB(1, 0), cB + kstep, voffB); PG8_STAGE(PG8_SA(1, 0), cA + kstep, voffA); PG8_STAGE(PG8_SB(1, 1), cB + hstep + kstep, voffB);
        PG8_WAIT_V(6); PG8_BAR;
    }
    for (;;) {
        const bool has_next = S.next(ui + 1, nxt);
        const char* nA = has_next ? (const char*)g.A + (size_t)nxt.pm * tstep : cA; const char* nB = has_next ? (const char*)g.Bt + (size_t)nxt.pn * tstep : cB;
        for (int t = 0; t < nt; t += 2) {
            const bool last = (t == nt - 2);
            const char* a1 = cA + (size_t)(t + 1) * kstep;
            const char* a2 = last ? nA : cA + (size_t)(t + 2) * kstep; const char* b2 = last ? nB : cB + (size_t)(t + 2) * kstep;
            const char* a3 = a2 + kstep; const char* b3 = b2 + kstep;
            if (last && has_next) S.a_ready(nxt);
            if constexpr (SP2) {
            PG8_LDB(B0, 0, 0); PG8_LDB(B1, 0, 1); PG8_SCHED; PG8_LDA(At, 0, 0); PG8_STAGE(PG8_SA(1, 1), a1 + hstep, voffA);
            PG8_WAIT_V(8); PG8_WAIT_L(0); PG8_BAR; PG8_MMA(0, 0, At, B0); PG8_MMA(0, 1, At, B1); PG8_BAR; PG8_SCHED;
            PG8_LDA(At, 0, 1); PG8_STAGE(PG8_SB(0, 0), b2, voffB); PG8_STAGE(PG8_SB(0, 1), b2 + hstep, voffB); PG8_STAGE(PG8_SA(0, 0), a2, voffA);
            PG8_WAIT_V(8); PG8_WAIT_L(0); PG8_BAR; PG8_MMA(1, 0, At, B0); PG8_MMA(1, 1, At, B1); PG8_BAR; PG8_SCHED;
            PG8_LDB(B0, 1, 0); PG8_LDB(B1, 1, 1); PG8_SCHED; PG8_LDA(At, 1, 0); PG8_STAGE(PG8_SA(0, 1), a2 + hstep, voffA);
            PG8_WAIT_V(8); PG8_WAIT_L(0); PG8_BAR; PG8_MMA(0, 0, At, B0); PG8_MMA(0, 1, At, B1); PG8_BAR; PG8_SCHED;
            PG8_LDA(At, 1, 1); PG8_STAGE(PG8_SB(1, 0), b3, voffB); PG8_STAGE(PG8_SB(1, 1), b3 + hstep, voffB); PG8_STAGE(PG8_SA(1, 0), a3, voffA);
            PG8_WAIT_V(8); PG8_WAIT_L(0); PG8_BAR; PG8_MMA(1, 0, At, B0); PG8_MMA(1, 1, At, B1); PG8_BAR; PG8_SCHED;
            } else {
            PG8_LDB(B0, 0, 0); PG8_SCHED; PG8_LDA(At, 0, 0); PG8_STAGE(PG8_SA(1, 1), a1 + hstep, voffA);
            PG8_WAIT_L(8); PG8_BAR; PG8_WAIT_L(0); PG8_MMA(0, 0, At, B0); PG8_BAR; PG8_SCHED;
            PG8_LDB(B1, 0, 1); PG8_STAGE(PG8_SB(0, 0), b2, voffB);
            PG8_BAR; PG8_WAIT_L(0); PG8_MMA(0, 1, At, B1); PG8_BAR;
            PG8_LDA(At, 0, 1); PG8_STAGE(PG8_SA(0, 0), a2, voffA);
            PG8_BAR; PG8_WAIT_L(0); PG8_MMA(1, 0, At, B0); PG8_BAR; PG8_SCHED;
            PG8_STAGE(PG8_SB(0, 1), b2 + hstep, voffB);
            PG8_WAIT_V(6); PG8_BAR; PG8_MMA(1, 1, At, B1); PG8_BAR;
            PG8_LDB(B0, 1, 0); PG8_SCHED; PG8_LDA(At, 1, 0); PG8_STAGE(PG8_SA(0, 1), a2 + hstep, voffA);
            PG8_WAIT_L(8); PG8_BAR; PG8_WAIT_L(0); PG8_MMA(0, 0, At, B0); PG8_BAR; PG8_SCHED;
            PG8_LDB(B1, 1, 1); PG8_STAGE(PG8_SB(1, 0), b3, voffB);
            PG8_BAR; PG8_WAIT_L(0); PG8_MMA(0, 1, At, B1); PG8_BAR;
            PG8_LDA(At, 1, 1); PG8_STAGE(PG8_SA(1, 0), a3, voffA);
            PG8_BAR; PG8_WAIT_L(0); PG8_MMA(1, 0, At, B0); PG8_BAR; PG8_SCHED;
            PG8_STAGE(PG8_SB(1, 1), b3 + hstep, voffB);
            PG8_WAIT_V(6); PG8_BAR; PG8_MMA(1, 1, At, B1); PG8_BAR;
            }
        }
        if constexpr (ALIGN_EPI) { if (wr == 0) PG8_BAR; }
        if constexpr (!Epi::AFTER_DRAIN) { E(acc, cur, wr, wc, fr, fq); S.done(cur); }
        if (!has_next) break;
#pragma unroll
        for (int a = 0; a < 2; ++a)
#pragma unroll
            for (int b = 0; b < 2; ++b)
#pragma unroll
                for (int m = 0; m < 4; ++m)
#pragma unroll
                    for (int n = 0; n < 2; ++n) acc[a][b][m][n] = (f32x4){0.f, 0.f, 0.f, 0.f};
        cur = nxt; cA = nA; cB = nB; ++ui;
        if constexpr (ALIGN_EPI) { if (wr == 1) PG8_BAR; }
    }
    PG8_WAIT_V(0);
    if constexpr (!ALIGN_EPI) { if (wr == 0) PG8_BAR; }
    PG8_BAR;
    if constexpr (Epi::AFTER_DRAIN) { E.fused(acc, cur, wr, wc, fr, fq, lds, wid, lane); S.done(cur); }
#undef PG8_SA
#undef PG8_SB
#undef PG8_STAGE
#undef PG8_LDA
#undef PG8_LDB
#undef PG8_MMA
#undef PG8_WAIT_V
#undef PG8_WAIT_L
#undef PG8_BAR
#undef PG8_SCHED
}
}

using namespace pg8;
#define LAS __attribute__((address_space(3)))
typedef float f32x16 __attribute__((ext_vector_type(16)));

constexpr int BATCH = 4, SEQ = 2048, M_TOK = BATCH * SEQ, DFF = 5632;
constexpr int PJ_LD = 8192;
constexpr int VT_LD = M_TOK;
constexpr float QA_SCALE = 0.125f * LOG2E, QB_SCALE = 0.08838834764831845f * LOG2E;

constexpr size_t MiB = 1u << 20;
constexpr size_t WS_SSQ0 = 0, WS_SSQ1 = 1 * MiB, WS_SSQ2 = 2 * MiB, WS_SSQ3 = 3 * MiB, WS_KMEAN = 4 * MiB, WS_XS = 4 * MiB + 512 * 1024, WS_BAR = 5 * MiB, BAR_BYTES = 32768;
constexpr size_t WS_WGU = 8 * MiB, WS_WDN = 52 * MiB, WS_WIN = 74 * MiB, WS_WV = 106 * MiB, WS_WPA = 114 * MiB, WS_WPB = 118 * MiB, WS_WO = 122 * MiB;
constexpr size_t WS_XB = 130 * MiB, WS_ACT = 162 * MiB, WS_OA = WS_ACT, WS_OB = WS_ACT + 16 * MiB, WS_PJ = 250 * MiB, WS_VT = 378 * MiB, WS_END = 410 * MiB;
constexpr size_t WS_WGU1 = WS_PJ, WS_WDN1 = WS_PJ + 44 * MiB;

constexpr int TAIL1_EXTRA = 7168;
constexpr int WGU2_EARLY = 0;
constexpr int LDS_BYTES = 147456;

__device__ __forceinline__ float wave_sum(float v) {
#pragma unroll
    for (int o = 1; o < 64; o <<= 1) v += __shfl_xor(v, o);
    return v;
}
struct ConvDesc { const float* src; bf16_t* dst; const float* g; int Nsrc, K; };
#ifndef CONV_MODE
#define CONV_MODE 1
#endif
__device__ __forceinline__ ConvDesc conv_desc(const float* W, int K, int Nsrc, int c0, int nc, bf16_t* WT, int r0, const float* g, int mode, int item) {
    const int nblk = nc / 64;
    int kb, nb;
    if (CONV_MODE == 0) { kb = item / nblk; nb = item % nblk; }
    else { const int j = item & 7, t = item >> 3; nb = t % nblk; kb = (t / nblk) * 8 + j; }
    const int loc = 64 * nb;
    int dst = r0 + loc;
    if (mode == 1) { const int half = nc / 2; const int l2 = loc < half ? loc : loc - half; dst = r0 + 256 * (l2 / 128) + (l2 % 128) + (loc < half ? 0 : 128); }
    ConvDesc d; d.src = W + (size_t)(64 * kb) * Nsrc + c0 + loc; d.dst = WT + (size_t)dst * K + 64 * kb; d.g = g ? g + 64 * kb : nullptr; d.Nsrc = Nsrc; d.K = K;
    return d;
}
__device__ __forceinline__ void conv_load(const ConvDesc& d, f32x4 (&v)[16], int lane) {
    const int kq = lane >> 4, n4 = (lane & 15) * 4;
    const float* src = d.src + (size_t)(2 * kq) * d.Nsrc + n4;
#pragma unroll
    for (int i = 0; i < 8; ++i) { v[2 * i] = __builtin_nontemporal_load((const f32x4*)(src + (size_t)(8 * i) * d.Nsrc)); v[2 * i + 1] = __builtin_nontemporal_load((const f32x4*)(src + (size_t)(8 * i + 1) * d.Nsrc)); }
}
__device__ __forceinline__ void conv_scatter(const ConvDesc& d, f32x4 (&v)[16], LAS unsigned* scr, int lane) {
    const int kq = lane >> 4, n4 = (lane & 15) * 4;
    if (d.g) {
#pragma unroll
        for (int i = 0; i < 8; ++i) { const f32x2 gg = *(const f32x2*)(d.g + 8 * i + 2 * kq); v[2 * i] = v[2 * i] * gg.x; v[2 * i + 1] = v[2 * i + 1] * gg.y; } }
#pragma unroll
    for (int i = 0; i < 8; ++i)
#pragma unroll
        for (int j = 0; j < 4; ++j) scr[(n4 + j) * 33 + 4 * i + kq] = cvt_pk_bf16(v[2 * i][j], v[2 * i + 1][j]);
}
__device__ __forceinline__ void conv_store(const ConvDesc& d, const LAS unsigned* scr, int lane) {
    const int c = lane & 7, nl = lane >> 3;
#pragma unroll
    for (int jj = 0; jj < 8; ++jj) { const int n = nl + 8 * jj; const LAS unsigned* sp = scr + n * 33 + 4 * c;
        u32x4 o; o.x = sp[0]; o.y = sp[1]; o.z = sp[2]; o.w = sp[3];
        *(u32x4*)(d.dst + (size_t)n * d.K + 8 * c) = o; }
}
__device__ __forceinline__ void conv_pair(const ConvDesc& A, const ConvDesc& B, bool hasB, LAS unsigned* scr, int lane) {
    f32x4 va[16], vb[16];
    conv_load(A, va, lane);
    if (hasB) conv_load(B, vb, lane);
    conv_scatter(A, va, scr, lane);
    if (hasB) conv_scatter(B, vb, scr + 2112, lane);
    asm volatile("s_waitcnt lgkmcnt(0)" ::: "memory");
    conv_store(A, scr, lane);
    if (hasB) conv_store(B, scr + 2112, lane);
    asm volatile("s_waitcnt lgkmcnt(0)" ::: "memory");
}

constexpr int ATT_KPMAX = 272, ATT_VP = 144;
constexpr int ATT_LDS_KB = 64 * ATT_KPMAX, ATT_LDS_V0 = 2 * ATT_LDS_KB, ATT_LDS_VB = 128 * ATT_VP;
constexpr float ATT_NEG = -1e30f;
#define MFMA32(a, b, c) __builtin_amdgcn_mfma_f32_32x32x16_bf16((a), (b), (c), 0, 0, 0)

template <int DH, bool MOBA>
__device__ __forceinline__ void flash_pass(LAS unsigned char* lds, const bf16_t* qrow, const bf16_t* kbase, const bf16_t* vtbase, int q0, int qblk, float sl2, unsigned sel, f32x16 (&o)[4], int tid) {
    const int lane = tid & 63, r32 = lane & 31, hi = lane >> 5, wid = __builtin_amdgcn_readfirstlane(tid >> 6);
    constexpr int KP = DH * 2 + 16, KPIECES = DH / 8, KLD = (64 * KPIECES) / 512;
    bf16x8 qf[DH / 16];
#pragma unroll
    for (int d0 = 0; d0 < DH / 16; ++d0) qf[d0] = *(const bf16x8*)(qrow + d0 * 16 + hi * 8);
    const int qw0 = q0 + wid * 32, qpos = qw0 + r32;
    float m_run = 0.f, l_run = 0.f;
#pragma unroll
    for (int d = 0; d < 4; ++d)
#pragma unroll
        for (int r = 0; r < 16; ++r) o[d][r] = 0.f;
    const int NT = 4 * (qblk + 1);
    const int pg = r32 >> 3, phh = (r32 >> 2) & 1, pt = r32 & 3, prow = 16 * (pg >> 1) + 8 * phh + 4 * (pg & 1) + pt;
    const unsigned kfo = prow * KP + hi * 16, vfo = r32 * ATT_VP + hi * 16;
    u32x4 kreg[KLD], vreg[2];
#define TILE_OF(i) (MOBA ? ((((i) < 4) ? qblk : (((i) >> 2) - 1)) * 4 + ((i) & 3)) : (i))
#define LOADG(tile) do { const int kv0_ = (tile) * 64; \
        _Pragma("unroll") for (int j = 0; j < KLD; ++j) { const int p = tid + 512 * j, row = p / KPIECES, c = p % KPIECES; kreg[j] = *(const u32x4*)(kbase + (size_t)(kv0_ + row) * PJ_LD + c * 8); } \
        _Pragma("unroll") for (int j = 0; j < 2; ++j) { const int p = tid + 512 * j, d = p >> 3, c = p & 7; vreg[j] = *(const u32x4*)(vtbase + (size_t)d * VT_LD + kv0_ + c * 8); } } while (0)
#define STORE_LDS(buf) do { \
        _Pragma("unroll") for (int j = 0; j < KLD; ++j) { const int p = tid + 512 * j, row = p / KPIECES, c = p % KPIECES; *(LAS u32x4*)(lds + (buf) * ATT_LDS_KB + row * KP + c * 16) = kreg[j]; } \
        _Pragma("unroll") for (int j = 0; j < 2; ++j) { const int p = tid + 512 * j, d = p >> 3, c = p & 7; *(LAS u32x4*)(lds + ATT_LDS_V0 + (buf) * ATT_LDS_VB + d * ATT_VP + c * 16) = vreg[j]; } } while (0)
    LOADG(TILE_OF(0)); STORE_LDS(0); __syncthreads();
#pragma unroll 1
    for (int i = 0; i < NT; ++i) {
        const int tile = TILE_OF(i), kv0 = tile * 64, blk = tile >> 2, buf = i & 1;
        { const int in_ = (i + 1 < NT) ? i + 1 : i; LOADG(TILE_OF(in_)); }
        const bool diag = (blk == qblk);
        bool active = !(diag && kv0 > qw0 + 31);
        const bool mysel = MOBA ? (((sel >> blk) & 1u) != 0u) : true;
        if (MOBA && !diag) { if (!__any(mysel ? 1 : 0)) active = false; }
        if (active) {
            const LAS unsigned char* Kb = lds + buf * ATT_LDS_KB; const LAS unsigned char* Vb = lds + ATT_LDS_V0 + buf * ATT_LDS_VB;
            f32x16 s[2];
            const float fb = sl2 * (float)(kv0 + 8 * hi - qpos) - m_run;
            const int thr = qpos - kv0 - 8 * hi;
            const bool need = (diag && kv0 + 63 > qw0) || (MOBA && !diag && !__all(mysel ? 1 : 0));
            int thr_eff = diag ? thr : 4096;
            if (MOBA) thr_eff = (!diag && !mysel) ? -4096 : thr_eff;
            constexpr int NQK = DH / 16, PER = 16 / NQK;
            {
                const float fb0 = fb, fb1 = fb + sl2 * 16.0f;
#pragma unroll
                for (int r = 0; r < 16; ++r) s[0][r] = ((r >> 3) ? fb1 : fb0) + sl2 * (float)(r & 7);
            }
            const float fb2 = fb + sl2 * 32.0f, fb3 = fb + sl2 * 48.0f;
            __builtin_amdgcn_s_setprio(1);
#pragma unroll
            for (int g0 = 0; g0 < NQK; g0 += 4) {
                bf16x8 kf[4];
#pragma unroll
                for (int j4 = 0; j4 < 4; ++j4) kf[j4] = *(const LAS bf16x8*)(Kb + kfo + (g0 + j4) * 32);
#pragma unroll
                for (int j4 = 0; j4 < 4; ++j4) { const int d0 = g0 + j4;
                    s[0] = MFMA32(kf[j4], qf[d0], s[0]);
#pragma unroll
                    for (int j = 0; j < PER; ++j) { const int r = d0 * PER + j; s[1][r] = ((r >> 3) ? fb3 : fb2) + sl2 * (float)(r & 7); }
                }
                __builtin_amdgcn_sched_barrier(0);
            }
            __builtin_amdgcn_s_setprio(0);
            if (need) {
#pragma unroll
                for (int r = 0; r < 16; ++r) s[0][r] = (16 * (r >> 3) + (r & 7) > thr_eff) ? ATT_NEG : s[0][r];
            }
            float mx = fmaxf(fmaxf(s[0][0], s[0][1]), s[0][2]);
#pragma unroll
            for (int r = 3; r < 15; r += 2) mx = fmaxf(fmaxf(mx, s[0][r]), s[0][r + 1]);
            mx = fmaxf(mx, s[0][15]);
            __builtin_amdgcn_sched_barrier(0);
            __builtin_amdgcn_s_setprio(1);
#pragma unroll
            for (int g0 = 0; g0 < NQK; g0 += 4) {
                bf16x8 kf[4];
#pragma unroll
                for (int j4 = 0; j4 < 4; ++j4) kf[j4] = *(const LAS bf16x8*)(Kb + kfo + 32 * KP + (g0 + j4) * 32);
#pragma unroll
                for (int j4 = 0; j4 < 4; ++j4) { const int d0 = g0 + j4;
                    s[1] = MFMA32(kf[j4], qf[d0], s[1]);
#pragma unroll
                    for (int j = 0; j < PER; ++j) { const int r = d0 * PER + j; s[0][r] = __builtin_amdgcn_exp2f(s[0][r]); asm volatile("" : "+v"(s[0][r])); }
                    __builtin_amdgcn_sched_barrier(0);
                }
            }
            __builtin_amdgcn_s_setprio(0);
            if (need) {
#pragma unroll
                for (int r = 0; r < 16; ++r) s[1][r] = (32 + 16 * (r >> 3) + (r & 7) > thr_eff) ? ATT_NEG : s[1][r];
            }
            mx = fmaxf(fmaxf(mx, s[1][0]), s[1][1]);
#pragma unroll
            for (int r = 2; r < 16; r += 2) mx = fmaxf(fmaxf(mx, s[1][r]), s[1][r + 1]);
            mx = fmaxf(mx, __shfl_xor(mx, 32));
            if (__any(mx > 8.0f ? 1 : 0)) {
                const float dl = fmaxf(mx, 0.f), alpha = __builtin_amdgcn_exp2f(-dl);
                m_run += dl; l_run *= alpha;
#pragma unroll
                for (int d = 0; d < 4; ++d)
#pragma unroll
                    for (int r = 0; r < 16; ++r) o[d][r] *= alpha;
#pragma unroll
                for (int r = 0; r < 16; ++r) { s[0][r] *= alpha; s[1][r] -= dl; }
            }
#define PACK8(S, B) __builtin_bit_cast(bf16x8, (u32x4){cvt_pk_bf16(S[B], S[B + 1]), cvt_pk_bf16(S[B + 2], S[B + 3]), cvt_pk_bf16(S[B + 4], S[B + 5]), cvt_pk_bf16(S[B + 6], S[B + 7])})
            float lsum = 0.f;
#pragma unroll
            for (int r = 0; r < 16; ++r) lsum += s[0][r];
            bf16x8 pb[4];
            pb[0] = PACK8(s[0], 0); pb[1] = PACK8(s[0], 8);
            __builtin_amdgcn_sched_barrier(0);
            __builtin_amdgcn_s_setprio(1);
#pragma unroll
            for (int c = 0; c < 2; ++c) {
                bf16x8 vf[4];
#pragma unroll
                for (int d = 0; d < 4; ++d) vf[d] = *(const LAS bf16x8*)(Vb + vfo + d * 32 * ATT_VP + c * 32);
#pragma unroll
                for (int d = 0; d < 4; ++d) { o[d] = MFMA32(vf[d], pb[c], o[d]);
                    s[1][(c * 4 + d) * 2] = __builtin_amdgcn_exp2f(s[1][(c * 4 + d) * 2]); s[1][(c * 4 + d) * 2 + 1] = __builtin_amdgcn_exp2f(s[1][(c * 4 + d) * 2 + 1]);
                    __builtin_amdgcn_sched_barrier(0); }
            }
            pb[2] = PACK8(s[1], 0); pb[3] = PACK8(s[1], 8);
            __builtin_amdgcn_sched_barrier(0);
#pragma unroll
            for (int c = 2; c < 4; ++c) {
                bf16x8 vf[4];
#pragma unroll
                for (int d = 0; d < 4; ++d) vf[d] = *(const LAS bf16x8*)(Vb + vfo + d * 32 * ATT_VP + c * 32);
#pragma unroll
                for (int d = 0; d < 4; ++d) { o[d] = MFMA32(vf[d], pb[c], o[d]);
                    lsum += s[1][((c - 2) * 4 + d) * 2] + s[1][((c - 2) * 4 + d) * 2 + 1];
                    __builtin_amdgcn_sched_barrier(0); }
            }
            __builtin_amdgcn_s_setprio(0);
            l_run += lsum;
#undef PACK8
        }
        STORE_LDS((i + 1) & 1);
        __syncthreads();
    }
#undef TILE_OF
#undef LOADG
#undef STORE_LDS
    const float lt = l_run + __shfl_xor(l_run, 32), inv = 1.0f / lt;
#pragma unroll
    for (int d = 0; d < 4; ++d)
#pragma unroll
        for (int r = 0; r < 16; ++r) o[d][r] *= inv;
}

#define XB_TMO      128
#define XB_XCNT(j)  (256  + 64 * (j))
#define XB_XSUB(j)  (1280 + 64 * (j))
#define XB_XGEN(j)  (2304 + 64 * (j))
#define XB_TOP      3328
#define XB_TOPGEN   3392
#define XCD_BAR_WORDS 3456
#define XB_SPIN_CAP (1u << 18)

__device__ __forceinline__ unsigned xb_ld(unsigned* p)              { return __hip_atomic_load(p, __ATOMIC_RELAXED, __HIP_MEMORY_SCOPE_AGENT); }
__device__ __forceinline__ unsigned xb_add(unsigned* p, unsigned v) { return __hip_atomic_fetch_add(p, v, __ATOMIC_RELAXED, __HIP_MEMORY_SCOPE_AGENT); }
__device__ __forceinline__ unsigned xb_xcc_id() { return (unsigned)__builtin_amdgcn_s_getreg((3 << 11) | 20) & 0xFu; }
#define XB_SPIN(cond, bar) do { unsigned _sp = 0; while (cond) { __builtin_amdgcn_s_sleep(1); \
    if ((++_sp & 255u) == 0u) { if (xb_ld(&(bar)[XB_TMO])) break; if (_sp > XB_SPIN_CAP) { atomicAdd(&(bar)[XB_TMO], 1u); break; } } } } while (0)

struct XcdBarrier {
    unsigned* bar; unsigned x;
    volatile LAS unsigned* st;
};

__device__ __forceinline__ XcdBarrier xcd_barrier_post(unsigned* bar, volatile LAS unsigned* st) {
    XcdBarrier b; b.bar = bar; b.x = xb_xcc_id(); b.st = st;
    if (threadIdx.x == 0) (void)xb_add(&bar[XB_XCNT(b.x)], 1u);
    return b;
}
__device__ __forceinline__ void xcd_barrier_complete(unsigned* bar, unsigned x, unsigned& nloc, unsigned& nx) {
    const unsigned G = gridDim.x * gridDim.y * gridDim.z;
    unsigned sum, cnt, mine, sp = 0u;
    for (;;) {
        sum = 0u; cnt = 0u; mine = 0u;
#pragma unroll
        for (unsigned j = 0; j < 16; ++j) { const unsigned c = xb_ld(&bar[XB_XCNT(j)]); sum += c; cnt += (c > 0u) ? 1u : 0u; mine = (j == x) ? c : mine; }
        if (sum == G) break;
        __builtin_amdgcn_s_sleep(1);
        if ((++sp & 255u) == 0u) { if (xb_ld(&bar[XB_TMO])) break; if (sp > XB_SPIN_CAP) { atomicAdd(&bar[XB_TMO], 1u); break; } }
    }
    nloc = mine > 0u ? mine : 1u; nx = cnt > 0u ? cnt : 1u;
}

__device__ __forceinline__ void xcd_barrier(const XcdBarrier& b) {
    asm volatile("s_waitcnt vmcnt(0)" ::: "memory");
    __syncthreads();
    if (threadIdx.x == 0) {
        unsigned* bar = b.bar;
        __builtin_amdgcn_s_waitcnt(0);
        unsigned nloc = b.st[0], nx = b.st[1];
        if (nloc == 0u) { xcd_barrier_complete(bar, b.x, nloc, nx); b.st[0] = nloc; b.st[1] = nx; }
        const unsigned old = xb_add(&bar[XB_XSUB(b.x)], 1u);
        const unsigned gen = old / nloc;
        if (old + 1u == (gen + 1u) * nloc) {
            __builtin_amdgcn_fence(__ATOMIC_RELEASE, "agent");
            asm volatile("s_waitcnt vmcnt(0)" ::: "memory");
            const unsigned og = xb_add(&bar[XB_TOP], 1u);
            const unsigned tg = og / nx;
            if (og + 1u == (tg + 1u) * nx) xb_add(&bar[XB_TOPGEN], 1u);
            else XB_SPIN(xb_ld(&bar[XB_TOPGEN]) == tg, bar);
            __builtin_amdgcn_fence(__ATOMIC_ACQUIRE, "agent");
            xb_add(&bar[XB_XGEN(b.x)], 1u);
            asm volatile("s_waitcnt vmcnt(0)" ::: "memory");
        } else {
            XB_SPIN(xb_ld(&bar[XB_XGEN(b.x)]) == gen, bar);
            __builtin_amdgcn_fence(__ATOMIC_ACQUIRE, "agent");
            asm volatile("s_waitcnt vmcnt(0)" ::: "memory");
        }
    }
    __syncthreads();
}

#ifndef PHASES
#define PHASES 0xFFFF
#endif
#ifndef DUP_MASK
#define DUP_MASK 0
#endif
#define REP(bit) _Pragma("unroll 1") for (int rep_ = 0; rep_ < 1 + ((DUP_MASK >> (bit)) & 1); ++rep_)
struct Args { const float* in[18]; float* out; unsigned char* ws; };

__global__ void __launch_bounds__(512, 2) mega_fwd(Args a) {
    extern __shared__ __attribute__((aligned(16))) unsigned char lds_raw[];
    LAS unsigned char* lds = (LAS unsigned char*)lds_raw;
    cg::grid_group grid = cg::this_grid();
    const int G = gridDim.x, NGW = G * 8;
    volatile LAS unsigned* bar_st = (volatile LAS unsigned*)(lds + LDS_BYTES - 64);
    if (threadIdx.x < 2) bar_st[threadIdx.x] = 0u;
    __syncthreads();
    const XcdBarrier xbar = xcd_barrier_post((unsigned*)(a.ws + WS_BAR), bar_st);
#define SEAM() xcd_barrier(xbar)
    if (a.out == nullptr) grid.sync();
#define PHASE_IDS() int tid_o = threadIdx.x; asm volatile("" : "+v"(tid_o)); const int tid = tid_o, lane = tid & 63, wave = __builtin_amdgcn_readfirstlane(tid >> 6), gw = blockIdx.x * 8 + wave; \
    LAS unsigned* scr = (LAS unsigned*)(lds + wave * 16896); (void)tid; (void)lane; (void)gw; (void)scr;
    unsigned char* ws = a.ws;
    float* SSQ0 = (float*)(ws + WS_SSQ0); float* SSQ1 = (float*)(ws + WS_SSQ1); float* SSQ2 = (float*)(ws + WS_SSQ2); float* SSQ3 = (float*)(ws + WS_SSQ3);
    float* KMEAN = (float*)(ws + WS_KMEAN);
    bf16_t* WGU = (bf16_t*)(ws + WS_WGU); bf16_t* WDN = (bf16_t*)(ws + WS_WDN); bf16_t* WGU1 = (bf16_t*)(ws + WS_WGU1); bf16_t* WDN1 = (bf16_t*)(ws + WS_WDN1); bf16_t* WIN = (bf16_t*)(ws + WS_WIN); bf16_t* WV = (bf16_t*)(ws + WS_WV);
    bf16_t* WPA = (bf16_t*)(ws + WS_WPA); bf16_t* WPB = (bf16_t*)(ws + WS_WPB); bf16_t* WO = (bf16_t*)(ws + WS_WO);
    bf16_t* XB = (bf16_t*)(ws + WS_XB); bf16_t* ACT = (bf16_t*)(ws + WS_ACT); bf16_t* OA = (bf16_t*)(ws + WS_OA); bf16_t* OB = (bf16_t*)(ws + WS_OB);
    bf16_t* PJ = (bf16_t*)(ws + WS_PJ); bf16_t* VT = (bf16_t*)(ws + WS_VT); bf16_t* MG = VT;
    float* STASH = (float*)(ws + WS_ACT + 32 * MiB);
    float* XR = a.out;

    if (PHASES & (1 << 0)) REP(0)
    {
        PHASE_IDS();
        constexpr int NI = 5632 + 1024 + 1024 + 2048 + 512 + 512 + 512 + 512 + 1024 + WGU2_EARLY;
#define P0_DESC(it_, D) do { int r = (it_); const float* W; int K, Nsrc, c0, nc, r0 = 0, mode = 0; bf16_t* WT; const float* g = nullptr; \
            if (r < 5632) { W = a.in[2]; K = 2048; Nsrc = 11264; c0 = 0; nc = 11264; WT = WGU1; g = a.in[1]; mode = 1; } \
            else if ((r -= 5632) < 1024) { W = a.in[5]; K = 2048; Nsrc = 10240; c0 = 0; nc = 2048; WT = WIN; r0 = 0; g = a.in[4]; } \
            else if ((r -= 1024) < 1024) { W = a.in[5]; K = 2048; Nsrc = 10240; c0 = 3072; nc = 2048; WT = WIN; r0 = 2048; g = a.in[4]; } \
            else if ((r -= 1024) < 2048) { W = a.in[5]; K = 2048; Nsrc = 10240; c0 = 6144; nc = 4096; WT = WIN; r0 = 4096; g = a.in[4]; } \
            else if ((r -= 2048) < 512) { W = a.in[5]; K = 2048; Nsrc = 10240; c0 = 2048; nc = 1024; WT = WV; r0 = 0; g = a.in[4]; } \
            else if ((r -= 512) < 512) { W = a.in[5]; K = 2048; Nsrc = 10240; c0 = 5120; nc = 1024; WT = WV; r0 = 1024; g = a.in[4]; } \
            else if ((r -= 512) < 512) { W = a.in[11]; K = 1024; Nsrc = 2048; c0 = 0; nc = 2048; WT = WPA; } \
            else if ((r -= 512) < 512) { W = a.in[12]; K = 1024; Nsrc = 2048; c0 = 0; nc = 2048; WT = WPB; } \
            else if ((r -= 512) < 1024) { W = a.in[13]; K = 2048; Nsrc = 2048; c0 = 0; nc = 2048; WT = WO; } \
            else { r -= 1024; W = a.in[15]; K = 2048; Nsrc = 11264; c0 = 0; nc = 11264; WT = WGU; g = a.in[14]; mode = 1; } \
            D = conv_desc(W, K, Nsrc, c0, nc, WT, r0, g, mode, r); } while (0)
        const bool skip_late = (G == 256);
        for (int it = gw; it < NI - (skip_late ? 7168 : 0); it += NGW) {
            ConvDesc A; P0_DESC(!skip_late ? it : (it < 5632 ? it : it + 7168), A);
            conv_pair(A, A, false, scr, lane);
        }
#undef P0_DESC
        const float* x = a.in[0];
        for (int row = gw; row < M_TOK; row += NGW) {
            const f32x4* xr = (const f32x4*)(x + (size_t)row * DMODEL) + lane; float s = 0.f;
            u32x2* ob = (u32x2*)(XB + (size_t)row * DMODEL) + lane;
            f32x4 xv[8];
#pragma unroll
            for (int j = 0; j < 8; ++j) xv[j] = __builtin_nontemporal_load(xr + 64 * j);
#pragma unroll
            for (int j = 0; j < 8; ++j) { const f32x4 v = xv[j]; s += (v[0] * v[0] + v[1] * v[1]) + (v[2] * v[2] + v[3] * v[3]); u32x2 w; w.x = cvt_pk_bf16(v[0], v[1]); w.y = cvt_pk_bf16(v[2], v[3]); ob[64 * j] = w; }
            s = wave_sum(s);
            if (lane < 32) SSQ0[(size_t)row * 32 + lane] = (lane == 0) ? s : 0.f;
        }
    }
    SEAM();

    if (PHASES & (1 << 1)) REP(1)
    {
    { Gemm g{XB, WGU1, M_TOK, 2 * DFF, DMODEL}; StaticOrder S; S.init(M_TOK, 2 * DFF, G, (int)blockIdx.x); EpiSwiglu E{ACT, DFF, SSQ0};
      gemm_phase<EpiSwiglu, StaticOrder, true, true>(lds, g, S, E); }
    {
        PHASE_IDS();
        const int nwg = (M_TOK / 256) * (2 * DFF / 256), rounds = (nwg + G - 1) / G, rem = nwg - (rounds - 1) * G;
        int first = gw, stride = NGW;
        if (rem < G) { first = ((int)blockIdx.x - rem) * 8 + wave; stride = (G - rem) * 8; if ((int)blockIdx.x < rem) first = 1 << 30; }
#define T1_DESC(it_, D) do { if ((it_) < 2816) D = conv_desc(a.in[3], 5632, 2048, 0, 2048, WDN1, 0, nullptr, 0, (it_)); \
            else if (G != 256) D = conv_desc(a.in[15], 2048, 11264, 0, 11264, WGU, 0, a.in[14], 1, (it_) - 2816 + WGU2_EARLY); \
            else if ((it_) < 2816 + 512) D = conv_desc(a.in[11], 1024, 2048, 0, 2048, WPA, 0, nullptr, 0, (it_) - 2816); \
            else if ((it_) < 2816 + 1024) D = conv_desc(a.in[12], 1024, 2048, 0, 2048, WPB, 0, nullptr, 0, (it_) - 2816 - 512); \
            else if ((it_) < 2816 + 2048) D = conv_desc(a.in[13], 2048, 2048, 0, 2048, WO, 0, nullptr, 0, (it_) - 2816 - 1024); \
            else if ((it_) < 2816 + 4096) D = conv_desc(a.in[5], 2048, 10240, 6144, 4096, WIN, 4096, a.in[4], 0, (it_) - 2816 - 2048); \
            else if ((it_) < 2816 + 5120) D = conv_desc(a.in[5], 2048, 10240, 0, 2048, WIN, 0, a.in[4], 0, (it_) - 2816 - 4096); \
            else if ((it_) < 2816 + 6144) D = conv_desc(a.in[5], 2048, 10240, 3072, 2048, WIN, 2048, a.in[4], 0, (it_) - 2816 - 5120); \
            else if ((it_) < 2816 + 6656) D = conv_desc(a.in[5], 2048, 10240, 2048, 1024, WV, 0, a.in[4], 0, (it_) - 2816 - 6144); \
            else D = conv_desc(a.in[5], 2048, 10240, 5120, 1024, WV, 1024, a.in[4], 0, (it_) - 2816 - 6656); } while (0)
        for (int it0 = first; it0 < (G == 256 ? 2816 + TAIL1_EXTRA - 2048 : 2816 + 5632 - WGU2_EARLY); it0 += stride) {
            const int it = (G == 256 && it0 >= 2816) ? it0 + 2048 : it0;
            ConvDesc A; T1_DESC(it, A);
            conv_pair(A, A, false, scr, lane);
        }
#undef T1_DESC
        __syncthreads();
    }
    }
    SEAM();
    if ((DUP_MASK >> 17) & 1) { _Pragma("unroll 1") for (int q = 0; q < 20; ++q) SEAM(); }
    if (PHASES & (1 << 2)) REP(2)
    { Gemm g{ACT, WDN1, M_TOK, DMODEL, DFF}; StaticOrder S; S.init(M_TOK, DMODEL, G, (int)blockIdx.x); EpiRes E{a.in[0], XR, XB, SSQ1, 0.5f};
      gemm_phase<EpiRes, StaticOrder, true, true>(lds, g, S, E); }
    SEAM();
    if (PHASES & (1 << 3)) REP(3)
    {
    { Gemm g{XB, WIN, M_TOK, PJ_LD, DMODEL}; StaticOrder S; S.init(M_TOK, PJ_LD, G, (int)blockIdx.x); EpiProj E{PJ, PJ_LD, SSQ1, QA_SCALE, QB_SCALE, KMEAN};
      gemm_phase<EpiProj, StaticOrder, true, true>(lds, g, S, E); }
    { Gemm g{WV, XB, 2048, M_TOK, DMODEL}; StaticOrder S; S.init(2048, M_TOK, G, (int)blockIdx.x); EpiVt E{VT, VT_LD, SSQ1};
      gemm_phase<EpiVt, StaticOrder, true, true>(lds, g, S, E); }
    }
    SEAM();
    if (PHASES & (1 << 5)) REP(5)
    {
        float lam;
        { int l_o = threadIdx.x; asm volatile("" : "+v"(l_o)); const int lane = l_o & 63; const float p1 = wave_sum(a.in[6][lane] * a.in[7][lane]), p2 = wave_sum(a.in[8][lane] * a.in[9][lane]); lam = __uint_as_float(__builtin_amdgcn_readfirstlane(__float_as_uint(expf(p1) - expf(p2) + 0.2f))); }
        unsigned* cnt_u = (unsigned*)(a.ws + WS_BAR) + 3600; unsigned* cnt_c = (unsigned*)(a.ws + WS_BAR) + 3968;
        volatile LAS unsigned* wq = (volatile LAS unsigned*)(lds + LDS_BYTES - 128);
        const int xq = (int)(blockIdx.x & 7);
#ifndef ATT_DYNAMIC
#define ATT_DYNAMIC 0
#endif
#pragma unroll 1
        for (int ustat = blockIdx.x;; ustat += G) {
            int ucode, useq;
            if (ATT_DYNAMIC) {
                __syncthreads();
                if (threadIdx.x == 0) wq[0] = __hip_atomic_fetch_add(cnt_u + 16 * xq, 1u, __ATOMIC_RELAXED, __HIP_MEMORY_SCOPE_AGENT);
                __syncthreads();
                const int useq8 = __builtin_amdgcn_readfirstlane((int)wq[0]);
                if (useq8 >= 64) break;
                ucode = (int)((0x809A1B2CD3E4F567ull >> (4 * (useq8 >> 2))) & 15ull);
                useq = (useq8 & 3) * 8 + xq;
            } else {
                if (G == 256) {
                    const int k = (int)blockIdx.x >> 5, ui = (ustat - (int)blockIdx.x) >> 8;
                    const int nu = (k == 0) ? 1 : (k == 7 ? 3 : 2);
                    if (ui >= nu * (1 + ((DUP_MASK >> 16) & 1))) break;
                    const unsigned codes = (k == 0) ? 0x007u : (k == 1) ? 0x006u : (k == 2) ? 0x015u : (k == 3) ? 0x024u : (k == 4) ? 0x0D3u : (k == 5) ? 0x0BFu : (k == 6) ? 0x0CEu : 0x89Au;
                    ucode = (int)((codes >> (4 * (ui % nu))) & 15u); useq = (int)blockIdx.x & 31;
                } else {
                if (ustat >= 512 * (1 + ((DUP_MASK >> 16) & 1))) break;
                const int us = ustat & 511;
                useq = us & 31; ucode = us < 256 ? (us >> 5) : (8 | (7 - ((us - 256) >> 5)));
                }
            }
            int tid_o = threadIdx.x; asm volatile("" : "+v"(tid_o));
            const int tid = tid_o, lane = tid & 63, r32 = lane & 31, hi = lane >> 5, wave = __builtin_amdgcn_readfirstlane(tid >> 6);
#ifndef TEST_ATT
#define TEST_ATT 3
#endif
            if (ucode < 8) { if (TEST_ATT & 1) {
                const int qblk = ucode & 7, bh = useq & 31, b = bh >> 3, h = bh & 7, q0 = qblk * 256;
                const float sl2 = exp2f(-(float)(h + 1)) * LOG2E;
                const size_t row = (size_t)b * SEQ + q0 + wave * 32 + r32;
                f32x16 o[4];
                f32x4* stash = (f32x4*)(STASH + ((size_t)blockIdx.x * 512 + tid) * 64);
#pragma unroll 1
                for (int mp = 0; mp < 2; ++mp) {
                    flash_pass<64, false>(lds, PJ + row * PJ_LD + h * 128 + mp * 64, PJ + (size_t)b * SEQ * PJ_LD + 1024 + h * 128 + mp * 64, VT + (size_t)(h * 128) * VT_LD + (size_t)b * SEQ, q0, qblk, sl2, 0u, o, tid);
                    if (mp == 0) {
#pragma unroll
                        for (int d = 0; d < 4; ++d)
#pragma unroll
                            for (int g4 = 0; g4 < 4; ++g4) stash[d * 4 + g4] = (f32x4){o[d][4 * g4], o[d][4 * g4 + 1], o[d][4 * g4 + 2], o[d][4 * g4 + 3]}; }
                }
                float ss = 0.f;
#pragma unroll
                for (int d = 0; d < 4; ++d) {
#pragma unroll
                    for (int g4 = 0; g4 < 4; ++g4) { const f32x4 s0 = stash[d * 4 + g4];
#pragma unroll
                        for (int j = 0; j < 4; ++j) { const float v = s0[j] - lam * o[d][4 * g4 + j]; o[d][4 * g4 + j] = v; ss += v * v; } }
                    __builtin_amdgcn_sched_barrier(0); }
                ss += __shfl_xor(ss, 32);
                const float rinv = rsqrtf(ss * (1.0f / 128.0f) + RMS_EPS) * 0.8f;
                bf16_t* op = OA + row * 1024 + h * 128;
#pragma unroll
                for (int d = 0; d < 4; ++d)
#pragma unroll
                    for (int g4 = 0; g4 < 4; ++g4) { const int dd = 32 * d + 8 * g4 + 4 * hi; const f32x4 gs = *(const f32x4*)(a.in[10] + dd);
                        u32x2 w; w.x = cvt_pk_bf16(o[d][4 * g4 + 0] * rinv * gs[0], o[d][4 * g4 + 1] * rinv * gs[1]); w.y = cvt_pk_bf16(o[d][4 * g4 + 2] * rinv * gs[2], o[d][4 * g4 + 3] * rinv * gs[3]);
                        *(u32x2*)(op + dd) = w; }
            } } else if (TEST_ATT & 2) {
                const int qblk = ucode & 7, bh = useq & 31, b = bh >> 3, h = bh & 7, q0 = qblk * 256;
                const float sl2 = exp2f(-(float)(h + 1)) * LOG2E;
                const size_t row = (size_t)b * SEQ + q0 + wave * 32 + r32;
                const bf16_t* qp = PJ + row * PJ_LD + 2048 + h * 128;
                unsigned sel = 0u;
                if (qblk <= 3) sel = (1u << qblk) - 1u;
                else {
                    float qv[64];
#pragma unroll
                    for (int i = 0; i < 8; ++i) { const u32x4 w = *(const u32x4*)(qp + 64 * hi + 8 * i);
                        qv[8 * i + 0] = bf_lo(w.x); qv[8 * i + 1] = bf_hi(w.x); qv[8 * i + 2] = bf_lo(w.y); qv[8 * i + 3] = bf_hi(w.y); qv[8 * i + 4] = bf_lo(w.z); qv[8 * i + 5] = bf_hi(w.z); qv[8 * i + 6] = bf_lo(w.w); qv[8 * i + 7] = bf_hi(w.w); }
                    LAS float* kml = (LAS float*)(lds + 73728);
                    for (int idx = tid; idx < qblk * 128; idx += 512) { const float* kp = KMEAN + (size_t)(b * 8 + (idx >> 7)) * 2048 + h * 128 + (idx & 127); kml[idx] = kp[0] + kp[1024]; }
                    __syncthreads();
                    float gs[7];
#pragma unroll
                    for (int j = 0; j < 7; ++j) { gs[j] = 0.f;
                        if (j < qblk) { const LAS f32x4* km = (const LAS f32x4*)(kml + j * 128 + 64 * hi); float acc = 0.f;
#pragma unroll
                            for (int i = 0; i < 16; ++i) { const f32x4 k4 = km[i]; acc += qv[4 * i] * k4[0] + qv[4 * i + 1] * k4[1] + qv[4 * i + 2] * k4[2] + qv[4 * i + 3] * k4[3]; }
                            gs[j] = acc + __shfl_xor(acc, 32); }
                        __builtin_amdgcn_sched_barrier(0); }
#pragma unroll
                    for (int t = 0; t < 3; ++t) { float best = -INFINITY; int bi = 0;
#pragma unroll
                        for (int j = 0; j < 7; ++j) { if (j < qblk && !((sel >> j) & 1u) && gs[j] > best) { best = gs[j]; bi = j; } }
                        sel |= 1u << bi; }
                }
                f32x16 o[4];
                flash_pass<128, true>(lds, qp, PJ + (size_t)b * SEQ * PJ_LD + 3072 + h * 128, VT + (size_t)(1024 + h * 128) * VT_LD + (size_t)b * SEQ, q0, qblk, sl2, sel, o, tid);
                bf16_t* op = OB + row * 1024 + h * 128;
#pragma unroll
                for (int d = 0; d < 4; ++d)
#pragma unroll
                    for (int g4 = 0; g4 < 4; ++g4) { const int dd = 32 * d + 8 * g4 + 4 * hi;
                        u32x2 w; w.x = cvt_pk_bf16(o[d][4 * g4 + 0], o[d][4 * g4 + 1]); w.y = cvt_pk_bf16(o[d][4 * g4 + 2], o[d][4 * g4 + 3]);
                        *(u32x2*)(op + dd) = w; }
            }
        }
        if (G == 256) {
            PHASE_IDS();
            unsigned* cnt_f = (unsigned*)(a.ws + WS_BAR) + 7040;
            volatile LAS unsigned* wq2 = (volatile LAS unsigned*)(lds + LDS_BYTES - 128);
#pragma unroll 1
            for (;;) {
                __syncthreads();
                if (threadIdx.x == 0) wq2[0] = __hip_atomic_fetch_add(cnt_f, 1u, __ATOMIC_RELAXED, __HIP_MEMORY_SCOPE_AGENT);
                __syncthreads();
                const int it = WGU2_EARLY + __builtin_amdgcn_readfirstlane((int)wq2[0]) * 8 + wave;
                if (it - wave >= 5632 + 2048) break;
                ConvDesc A;
                if (it < 5632) A = conv_desc(a.in[15], 2048, 11264, 0, 11264, WGU, 0, a.in[14], 1, it);
                else if (it < 5632 + 512) A = conv_desc(a.in[11], 1024, 2048, 0, 2048, WPA, 0, nullptr, 0, it - 5632);
                else if (it < 5632 + 1024) A = conv_desc(a.in[12], 1024, 2048, 0, 2048, WPB, 0, nullptr, 0, it - 5632 - 512);
                else A = conv_desc(a.in[13], 2048, 2048, 0, 2048, WO, 0, nullptr, 0, it - 5632 - 1024);
                conv_pair(A, A, false, scr, lane);
            }
            __syncthreads();
        }
        if (ATT_DYNAMIC) {
            PHASE_IDS();
#pragma unroll 1
            for (;;) {
                unsigned itv = 0u; if (lane == 0) itv = __hip_atomic_fetch_add(cnt_c, 1u, __ATOMIC_RELAXED, __HIP_MEMORY_SCOPE_AGENT);
                const int it = __builtin_amdgcn_readfirstlane((int)itv);
                if (it >= 5632) break;
                const ConvDesc A = conv_desc(a.in[15], 2048, 11264, 0, 11264, WGU, 0, a.in[14], 1, it);
                conv_pair(A, A, false, scr, lane);
            }
        }
    }
    SEAM();
    if (PHASES & (1 << 6)) REP(6)
    {
    { Gemm g{OA, WPA, M_TOK, DMODEL, 1024}; StaticOrder S; S.init(M_TOK, DMODEL, G, (int)blockIdx.x); EpiGate<true> E{MG, PJ + 4096, PJ_LD};
      gemm_phase<EpiGate<true>, StaticOrder, true, true>(lds, g, S, E); }
    { Gemm g{OB, WPB, M_TOK, DMODEL, 1024}; StaticOrder S; S.init(M_TOK, DMODEL, G, (int)blockIdx.x); EpiGate<false> E{MG, PJ + 6144, PJ_LD};
      gemm_phase<EpiGate<false>, StaticOrder, true, true>(lds, g, S, E); }
    }
    SEAM();
    if (PHASES & (1 << 7)) REP(7)
    { Gemm g{MG, WO, M_TOK, DMODEL, DMODEL}; StaticOrder S; S.init(M_TOK, DMODEL, G, (int)blockIdx.x); EpiRes E{XR, XR, XB, SSQ2, 1.0f};
      gemm_phase<EpiRes, StaticOrder, true, true>(lds, g, S, E); }
    SEAM();
    if (PHASES & (1 << 8)) REP(8)
    {
    { Gemm g{XB, WGU, M_TOK, 2 * DFF, DMODEL}; StaticOrder S; S.init(M_TOK, 2 * DFF, G, (int)blockIdx.x); EpiSwiglu E{ACT, DFF, SSQ2};
      gemm_phase<EpiSwiglu, StaticOrder, true, true>(lds, g, S, E); }
    {
        PHASE_IDS();
        const int nwg = (M_TOK / 256) * (2 * DFF / 256), rounds = (nwg + G - 1) / G, rem = nwg - (rounds - 1) * G;
        int first = gw, stride = NGW;
        if (rem < G) { first = ((int)blockIdx.x - rem) * 8 + wave; stride = (G - rem) * 8; if ((int)blockIdx.x < rem) first = 1 << 30; }
        for (int it = first; it < 2816; it += stride) {
            const ConvDesc A = conv_desc(a.in[16], 5632, 2048, 0, 2048, WDN, 0, nullptr, 0, it);
            conv_pair(A, A, false, scr, lane);
        }
        __syncthreads();
    }
    }
    SEAM();
    if (G == 256) {
        Gemm g{ACT, WDN, M_TOK, DMODEL, DFF}; StaticOrder S; S.init(M_TOK, DMODEL, G, (int)blockIdx.x);
        EpiResNorm E{XR, XR, a.in[17], 0.5f, (float*)(ws + WS_XS), (unsigned*)(ws + WS_BAR) + 4096};
        gemm_phase<EpiResNorm, StaticOrder, false, true>(lds, g, S, E);
    } else {
    { Gemm g{ACT, WDN, M_TOK, DMODEL, DFF}; StaticOrder S; S.init(M_TOK, DMODEL, G, (int)blockIdx.x); EpiRes E{XR, XR, nullptr, SSQ3, 0.5f};
      gemm_phase<EpiRes, StaticOrder, true, true>(lds, g, S, E); }
    SEAM();
    {
        PHASE_IDS();
        const f32x4* gf = (const f32x4*)a.in[17] + lane;
        for (int row = gw; row < M_TOK; row += NGW) {
            const float rs = row_rstd(SSQ3, row);
            f32x4* xr = (f32x4*)(XR + (size_t)row * DMODEL) + lane;
            f32x4 xv[8];
#pragma unroll
            for (int j = 0; j < 8; ++j) xv[j] = xr[64 * j];
#pragma unroll
            for (int j = 0; j < 8; ++j) xr[64 * j] = xv[j] * rs * gf[64 * j];
        }
    }
    }
}

extern "C" void kernel_launch(void* const* d_in, const int* in_sizes, int n_in, void* d_out, int out_size, void* d_ws, size_t ws_size, hipStream_t stream) {
    static int grid_blocks = 0;
    if (grid_blocks == 0) {
        if (n_in != 18 || out_size != M_TOK * DMODEL || ws_size < WS_END) { fprintf(stderr, "kernel_launch: unexpected shapes (n_in %d out %d ws %zu)\n", n_in, out_size, ws_size); grid_blocks = -1; return; }
        int dev = 0, cus = 0, per_cu = 0;
        (void)hipGetDevice(&dev);
        (void)hipDeviceGetAttribute(&cus, hipDeviceAttributeMultiprocessorCount, dev);
        (void)hipFuncSetAttribute((const void*)mega_fwd, hipFuncAttributeMaxDynamicSharedMemorySize, LDS_BYTES);
        (void)hipOccupancyMaxActiveBlocksPerMultiprocessor(&per_cu, (const void*)mega_fwd, 512, LDS_BYTES);
        if (per_cu < 1) { fprintf(stderr, "kernel_launch: occupancy query says %d blocks per CU\n", per_cu); per_cu = 1; }
        grid_blocks = cus < 256 ? cus : 256;
        (void)hipGetLastError();
    }
    if (grid_blocks < 0) return;
    (void)hipMemsetAsync((unsigned char*)d_ws + WS_BAR, 0, BAR_BYTES, stream);
    Args a{};
    for (int i = 0; i < 18; ++i) a.in[i] = (const float*)d_in[i];
    a.out = (float*)d_out; a.ws = (unsigned char*)d_ws;
    void* args[] = {&a};
    hipError_t e = hipLaunchCooperativeKernel((const void*)mega_fwd, dim3(grid_blocks), dim3(512), args, LDS_BYTES, stream);
    if (e != hipSuccess) fprintf(stderr, "cooperative launch failed: %s (grid %d)\n", hipGetErrorString(e), grid_blocks);
}
```
